# Optimizing an MI355X kernel written in HIP

```python
import math
import jax
import jax.numpy as jnp
from jax import lax
import numpy as np

D_MODEL = 2048
BATCH = 2
SEQ = 16384
DEPTH = 4

N_MEM = 256
N_BRANCH = 4
MIX_W = D_MODEL // 4
HEAD_DIM = 128
N_MIX_HEADS = MIX_W // HEAD_DIM

HG_HEADS = N_MIX_HEADS
HG_DK = HEAD_DIM
HG_DV = MIX_W // HG_HEADS
HG_CHUNK = 64

DA_HEADS = N_MIX_HEADS
DA_DV = MIX_W // DA_HEADS
DA_DC = DA_DV // 2

NSA_HEADS = N_MIX_HEADS
NSA_DK = HEAD_DIM
NSA_DV = MIX_W // NSA_HEADS
CMP_LEN = 32
CMP_STRIDE = 16
CMP_HIDDEN = 2 * NSA_DK
SLC_BLOCK = 64
SLC_TOPK = 16
N_LOCAL_BLOCKS = 2
SWA_WINDOW = 512
CMP_R = CMP_LEN // CMP_STRIDE
SLC_R = SLC_BLOCK // CMP_STRIDE
SLC_OVERLAP_W = tuple(float(min(w + 1, CMP_R, SLC_R + CMP_R - 1 - w)) for w in range(SLC_R + CMP_R - 1))

GM_GROUPS = N_MIX_HEADS
GM_DG = MIX_W // GM_GROUPS
GM_CHUNK = 128

XA_HEADS = 4
XA_DH = D_MODEL // XA_HEADS
D_FF = -(-(8 * D_MODEL) // (3 * 256)) * 256

Q_BLOCK = 128
NEG = -1e30
TINY = 1e-30
FORCE_SCORE = 1e4

IN_SIZES = (
    HG_HEADS * HG_DK, HG_HEADS * HG_DK, HG_HEADS * HG_DV, HG_HEADS * HG_DV,
    DA_HEADS * 2 * DA_DC, DA_HEADS * 2 * DA_DC, DA_HEADS * DA_DV,
    NSA_HEADS * NSA_DK, NSA_DK, NSA_DV, NSA_DK, NSA_DV, NSA_DK, NSA_DV,
    3 * NSA_HEADS,
    2 * MIX_W,
    N_BRANCH * D_MODEL,
)
IN_SPLITS = tuple(int(c) for c in np.cumsum(IN_SIZES)[:-1])
N_IN = int(sum(IN_SIZES))

kernel_name = 'hybrid_gated_parallel_mixer_trunk'


def rmsnorm(x, w, eps=1e-6):
    xf = x.astype(jnp.float32)
    y = xf * lax.rsqrt(jnp.mean(xf * xf, axis=-1, keepdims=True) + eps)
    return (y * w.astype(jnp.float32)).astype(x.dtype)


def layernorm(x, w, b, eps=1e-5):
    xf = x.astype(jnp.float32)
    mu = jnp.mean(xf, axis=-1, keepdims=True)
    var = jnp.mean(jnp.square(xf - mu), axis=-1, keepdims=True)
    y = (xf - mu) * lax.rsqrt(var + eps)
    return (y * w.astype(jnp.float32) + b.astype(jnp.float32)).astype(x.dtype)


def masked_softmax(s, mask):
    s = jnp.where(mask, s.astype(jnp.float32), NEG)
    m = jnp.max(s, axis=-1, keepdims=True)
    p = jnp.where(mask, jnp.exp(s - m), 0.0)
    return p / jnp.maximum(jnp.sum(p, axis=-1, keepdims=True), TINY)


def hgrn2_mixer(q, f_logit, i, g, lower_bound, norm_w):
    B, S, _ = q.shape
    H, DK, DV, C = HG_HEADS, HG_DK, HG_DV, HG_CHUNK
    NC = S // C
    qf = jax.nn.silu(q.astype(jnp.float32))
    f = lower_bound + (1.0 - lower_bound) * jax.nn.sigmoid(f_logit.astype(jnp.float32))
    k = 1.0 - f
    log_f = jnp.log(f)

    def to_chunks(t):
        return t.reshape(B, NC, C, H, t.shape[-1] // H).transpose(1, 0, 3, 2, 4)

    qc, kc, vc, lc = (to_chunks(t) for t in (qf, k, i.astype(jnp.float32), log_f))
    causal = jnp.tril(jnp.ones((C, C), dtype=bool))[:, :, None]

    def step(state, inp):
        qb, kb, vb, lb = inp
        b = jnp.cumsum(lb, axis=2)
        o_inter = jnp.einsum('bhtk,bhkv->bhtv', qb * jnp.exp(b), state)
        rel = jnp.where(causal, b[:, :, :, None, :] - b[:, :, None, :, :], -jnp.inf)
        scores = jnp.einsum('bhtk,bhsk,bhtsk->bhts', qb, kb, jnp.exp(rel))
        o_intra = jnp.einsum('bhts,bhsv->bhtv', scores, vb)
        b_end = b[:, :, -1:, :]
        new_state = (jnp.exp(b_end[:, :, 0, :])[..., None] * state
                     + jnp.einsum('bhsk,bhsv->bhkv', kb * jnp.exp(b_end - b), vb))
        return new_state, o_inter + o_intra

    state0 = jnp.zeros((B, H, DK, DV), jnp.float32)
    _, o = lax.scan(step, state0, (qc, kc, vc, lc))
    o = o.transpose(1, 0, 3, 2, 4).reshape(B, S, H, DV)
    o = rmsnorm(o, norm_w).reshape(B, S, H * DV) * jax.nn.silu(g.astype(jnp.float32))
    return o.astype(q.dtype)


def diff_attention_mixer(q, k, v, lq1, lk1, lq2, lk2, norm_w, lambda_init):
    B, S, _ = q.shape
    H, DC, DV, QB = DA_HEADS, DA_DC, DA_DV, Q_BLOCK
    nb = S // QB
    out_dtype = v.dtype
    qb_all = q.reshape(B, nb, QB, H, 2, DC).swapaxes(0, 1)
    k = k.reshape(B, S, H, 2, DC)
    v = v.reshape(B, S, H, DV).astype(jnp.float32)
    lam = (jnp.exp(jnp.sum(lq1.astype(jnp.float32) * lk1.astype(jnp.float32)))
           - jnp.exp(jnp.sum(lq2.astype(jnp.float32) * lk2.astype(jnp.float32))) + lambda_init)
    scale = DC ** -0.5
    kpos = jnp.arange(S)

    def block(args):
        idx, qb = args
        qpos = idx * QB + jnp.arange(QB)
        s = jnp.einsum('bqhcd,bkhcd->bhcqk', qb, k).astype(jnp.float32) * scale
        s = jnp.where(kpos[None, :] <= qpos[:, None], s, NEG)
        p = jax.nn.softmax(s, axis=-1)
        w = p[:, :, 0] - lam * p[:, :, 1]
        return jnp.einsum('bhqk,bkhv->bqhv', w, v)

    o = lax.map(block, (jnp.arange(nb), qb_all))
    o = o.swapaxes(0, 1).reshape(B, S, H, DV)
    o = rmsnorm(o, norm_w) * (1.0 - lambda_init)
    return o.reshape(B, S, H * DV).astype(out_dtype)


def compress_tokens(t, pos, w1, w2):
    B, S, d = t.shape
    n_chunks = S // CMP_STRIDE
    n_cmp = n_chunks - CMP_R + 1
    tr = t.reshape(B, n_chunks, CMP_STRIDE, d)
    blocks = jnp.concatenate([tr[:, m:m + n_cmp] for m in range(CMP_R)], axis=2) + pos
    flat = blocks.reshape(B, n_cmp, CMP_LEN * d)
    return jax.nn.silu(flat @ w1) @ w2


def nsa_mixer(q, k_cmp, v_cmp, k_slc, v_slc, k_swa, v_swa, gate_logits,
              pos_k, w1_k, w2_k, pos_v, w1_v, w2_v):
    B, S, _ = q.shape
    H, DK, DV, QB = NSA_HEADS, NSA_DK, NSA_DV, Q_BLOCK
    nb = S // QB
    out_dtype = q.dtype
    scale = DK ** -0.5
    gates = jax.nn.sigmoid(gate_logits.astype(jnp.float32)).reshape(B, S, H, 3)

    kc = compress_tokens(k_cmp, pos_k, w1_k, w2_k)
    vc = compress_tokens(v_cmp, pos_v, w1_v, w2_v)
    n_cmp = kc.shape[1]
    cmp_end = jnp.arange(n_cmp) * CMP_STRIDE + CMP_LEN - 1

    n_slc = S // SLC_BLOCK
    topk = min(SLC_TOPK, n_slc)
    ks_blocks = k_slc.reshape(B, n_slc, SLC_BLOCK, DK)
    vs_blocks = v_slc.reshape(B, n_slc, SLC_BLOCK, DV)
    blk = jnp.arange(n_slc)

    k_swa_pad = jnp.pad(k_swa, ((0, 0), (SWA_WINDOW, 0), (0, 0)))
    v_swa_pad = jnp.pad(v_swa, ((0, 0), (SWA_WINDOW, 0), (0, 0)))

    q_all = q.reshape(B, nb, QB, H, DK).swapaxes(0, 1)
    g_all = gates.reshape(B, nb, QB, H, 3).swapaxes(0, 1)

    def block(args):
        idx, qb, gb = args
        qpos = idx * QB + jnp.arange(QB)
        s = jnp.einsum('bqhd,bnd->bhqn', qb, kc) * scale
        p_cmp = masked_softmax(s, cmp_end[None, :] <= qpos[:, None])
        o_cmp = jnp.einsum('bhqn,bnd->bqhd', p_cmp, vc.astype(jnp.float32))
        imp = jnp.pad(jnp.sum(p_cmp, axis=1), ((0, 0), (0, 0), (CMP_R - 1, CMP_R - 1)))
        span = SLC_R * (n_slc - 1) + 1
        imp = sum(w * imp[..., o:o + span:SLC_R] for o, w in enumerate(SLC_OVERLAP_W))
        cur = (qpos // SLC_BLOCK)[:, None]
        valid = blk[None, :] <= cur
        forced = (blk[None, :] == 0) | (blk[None, :] > cur - N_LOCAL_BLOCKS)
        score = jnp.where(valid, jnp.where(forced, FORCE_SCORE, imp), -1.0)
        _, sel = lax.top_k(score, topk)
        ks_sel = jax.vmap(lambda kb, ib: kb[ib])(ks_blocks, sel)
        vs_sel = jax.vmap(lambda vb, ib: vb[ib])(vs_blocks, sel)
        tok_pos = sel[..., None] * SLC_BLOCK + jnp.arange(SLC_BLOCK)
        smask = (tok_pos <= qpos[None, :, None, None]).reshape(B, 1, QB, topk * SLC_BLOCK)
        s = jnp.einsum('bqhd,bqnjd->bhqnj', qb, ks_sel) * scale
        p = masked_softmax(s.reshape(B, H, QB, topk * SLC_BLOCK), smask)
        o_slc = jnp.einsum('bhqm,bqmd->bqhd', p,
                           vs_sel.reshape(B, QB, topk * SLC_BLOCK, DV).astype(jnp.float32))
        start = idx * QB
        kw = lax.dynamic_slice_in_dim(k_swa_pad, start, SWA_WINDOW + QB, axis=1)
        vw = lax.dynamic_slice_in_dim(v_swa_pad, start, SWA_WINDOW + QB, axis=1)
        kpos = start - SWA_WINDOW + jnp.arange(SWA_WINDOW + QB)
        dist = qpos[:, None] - kpos[None, :]
        wmask = (dist >= 0) & (dist < SWA_WINDOW) & (kpos[None, :] >= 0)
        s = jnp.einsum('bqhd,bkd->bhqk', qb, kw) * scale
        p = masked_softmax(s, wmask)
        o_swa = jnp.einsum('bhqk,bkd->bqhd', p, vw.astype(jnp.float32))
        return gb[..., 0:1] * o_cmp + gb[..., 1:2] * o_slc + gb[..., 2:3] * o_swa

    o = lax.map(block, (jnp.arange(nb), q_all, g_all))
    return o.swapaxes(0, 1).reshape(B, S, H * DV).astype(out_dtype)


def chunk_gmlp_mixer(z, ln_w, ln_b, w_s, b_s):
    B, S, _ = z.shape
    G, DG, C = GM_GROUPS, GM_DG, GM_CHUNK
    NC = S // C
    z = jax.nn.gelu(z)
    u, v = jnp.split(z, 2, axis=-1)
    v = layernorm(v, ln_w, ln_b).reshape(B, NC, C, G, DG)
    w_causal = w_s * jnp.tril(jnp.ones((C, C), dtype=w_s.dtype))
    vm = jnp.einsum('gts,bnsgd->bntgd', w_causal, v) + b_s.T[None, None, :, :, None]
    return u * vm.reshape(B, S, MIX_W)


def cross_attention(h, mem_n, w_q, w_kv, w_o):
    B, S, _ = h.shape
    M = mem_n.shape[1]
    q = (h @ w_q).reshape(B, S, XA_HEADS, XA_DH)
    k, v = jnp.split(mem_n @ w_kv, 2, axis=-1)
    k = k.reshape(B, M, XA_HEADS, XA_DH)
    v = v.reshape(B, M, XA_HEADS, XA_DH)
    s = jnp.einsum('bshd,bmhd->bhsm', q, k).astype(jnp.float32) * (XA_DH ** -0.5)
    p = jax.nn.softmax(s, axis=-1).astype(h.dtype)
    o = jnp.einsum('bhsm,bmhd->bshd', p, v).reshape(B, S, D_MODEL)
    return o @ w_o


def swiglu_ffn(h, w_in, w_out):
    gate, up = jnp.split(h @ w_in, 2, axis=-1)
    return (jax.nn.silu(gate) * up) @ w_out


def setup_inputs(seed: int = 0) -> dict:
    key = jax.random.key(seed)
    keys = jax.random.split(key, 48)
    ctr = [0]

    def nrm(shape, scale):
        k = keys[ctr[0]]
        ctr[0] += 1
        return jax.random.normal(k, shape, jnp.float32) * scale

    def gain(shape):
        return 1.0 + nrm(shape, 0.05)

    L, D = DEPTH, D_MODEL
    return {
        'x': nrm((BATCH, SEQ, D), 1.0),
        'mem': nrm((BATCH, N_MEM, D), 1.0),
        'mem_norm_w': gain((D,)),
        'mix_norm_w': gain((L, D)),
        'w_in': nrm((L, D, N_IN), D ** -0.5),
        'hg_lower_bounds': nrm((L, HG_HEADS * HG_DK), 0.1),
        'hg_norm_w': gain((L, HG_DV)),
        'da_lambda_q1': nrm((L, DA_DC), 0.1),
        'da_lambda_k1': nrm((L, DA_DC), 0.1),
        'da_lambda_q2': nrm((L, DA_DC), 0.1),
        'da_lambda_k2': nrm((L, DA_DC), 0.1),
        'da_norm_w': gain((L, DA_DV)),
        'nsa_pos_k': nrm((L, CMP_LEN, NSA_DK), 0.1),
        'nsa_cmp_w1_k': nrm((L, CMP_LEN * NSA_DK, CMP_HIDDEN), (CMP_LEN * NSA_DK) ** -0.5),
        'nsa_cmp_w2_k': nrm((L, CMP_HIDDEN, NSA_DK), CMP_HIDDEN ** -0.5),
        'nsa_pos_v': nrm((L, CMP_LEN, NSA_DV), 0.1),
        'nsa_cmp_w1_v': nrm((L, CMP_LEN * NSA_DV, CMP_HIDDEN), (CMP_LEN * NSA_DV) ** -0.5),
        'nsa_cmp_w2_v': nrm((L, CMP_HIDDEN, NSA_DV), CMP_HIDDEN ** -0.5),
        'gm_ln_w': gain((L, MIX_W)),
        'gm_ln_b': nrm((L, MIX_W), 0.02),
        'gm_w_s': nrm((L, GM_GROUPS, GM_CHUNK, GM_CHUNK), GM_CHUNK ** -0.5),
        'gm_b_s': 1.0 + nrm((L, GM_GROUPS, GM_CHUNK), 0.1),
        'w_branch': nrm((L, N_BRANCH, MIX_W, D), MIX_W ** -0.5),
        'w_out': nrm((L, D, D), D ** -0.5),
        'xa_norm_w': gain((L, D)),
        'xa_w_q': nrm((L, D, D), D ** -0.5),
        'xa_w_kv': nrm((L, D, 2 * D), D ** -0.5),
        'xa_w_o': nrm((L, D, D), D ** -0.5),
        'ffn_norm_w': gain((L, D)),
        'ffn_w_in': nrm((L, D, 2 * D_FF), D ** -0.5),
        'ffn_w_out': nrm((L, D_FF, D), D_FF ** -0.5),
        'final_norm_w': gain((D,)),
    }


def reference(x, mem, mem_norm_w, mix_norm_w, w_in, hg_lower_bounds, hg_norm_w,
              da_lambda_q1, da_lambda_k1, da_lambda_q2, da_lambda_k2, da_norm_w,
              nsa_pos_k, nsa_cmp_w1_k, nsa_cmp_w2_k, nsa_pos_v, nsa_cmp_w1_v, nsa_cmp_w2_v,
              gm_ln_w, gm_ln_b, gm_w_s, gm_b_s, w_branch, w_out,
              xa_norm_w, xa_w_q, xa_w_kv, xa_w_o, ffn_norm_w, ffn_w_in, ffn_w_out,
              final_norm_w):
    B, S, _ = x.shape
    mem_n = rmsnorm(mem, mem_norm_w)
    lb_soft = jax.nn.softmax(hg_lower_bounds.astype(jnp.float32), axis=0)
    lower_bounds = jnp.cumsum(lb_soft, axis=0) - lb_soft[0]
    for l in range(DEPTH):
        h = rmsnorm(x, mix_norm_w[l])
        (hq, hf, hi, hg, dq, dk, dv, nq, nkc, nvc, nks, nvs, nkw, nvw, ngate, gz,
         gate_logits) = jnp.split(h @ w_in[l], IN_SPLITS, axis=-1)
        lambda_init = 0.8 - 0.6 * math.exp(-0.3 * l)
        o_a = hgrn2_mixer(hq, hf, hi, hg, lower_bounds[l], hg_norm_w[l])
        o_b = diff_attention_mixer(dq, dk, dv, da_lambda_q1[l], da_lambda_k1[l],
                                   da_lambda_q2[l], da_lambda_k2[l], da_norm_w[l], lambda_init)
        o_c = nsa_mixer(nq, nkc, nvc, nks, nvs, nkw, nvw, ngate,
                        nsa_pos_k[l], nsa_cmp_w1_k[l], nsa_cmp_w2_k[l],
                        nsa_pos_v[l], nsa_cmp_w1_v[l], nsa_cmp_w2_v[l])
        o_d = chunk_gmlp_mixer(gz, gm_ln_w[l], gm_ln_b[l], gm_w_s[l], gm_b_s[l])
        gates = jax.nn.sigmoid(gate_logits).reshape(B, S, N_BRANCH, D_MODEL)
        merged = gates[:, :, 0] * (o_a @ w_branch[l, 0])
        merged = merged + gates[:, :, 1] * (o_b @ w_branch[l, 1])
        merged = merged + gates[:, :, 2] * (o_c @ w_branch[l, 2])
        merged = merged + gates[:, :, 3] * (o_d @ w_branch[l, 3])
        x = x + merged @ w_out[l]
        x = x + cross_attention(rmsnorm(x, xa_norm_w[l]), mem_n, xa_w_q[l], xa_w_kv[l], xa_w_o[l])
        x = x + swiglu_ffn(rmsnorm(x, ffn_norm_w[l]), ffn_w_in[l], ffn_w_out[l])
    return rmsnorm(x, final_norm_w)
```

```cpp
#include <hip/hip_runtime.h>
#include <cstdio>
#include <cstdint>

#ifndef MK_N_LAUNCHES
#define MK_N_LAUNCHES 1
#endif

#define LAS __attribute__((address_space(3)))
typedef unsigned short bf16_t;
typedef short bf16x8 __attribute__((ext_vector_type(8)));
typedef short s16x4 __attribute__((ext_vector_type(4)));
typedef float f32x4 __attribute__((ext_vector_type(4)));
typedef float f32x2 __attribute__((ext_vector_type(2)));
typedef float f32x16 __attribute__((ext_vector_type(16)));
typedef unsigned u32x4 __attribute__((ext_vector_type(4)));
typedef unsigned u32x2 __attribute__((ext_vector_type(2)));
typedef int i32x4 __attribute__((ext_vector_type(4)));
typedef int i32x8 __attribute__((ext_vector_type(8)));

constexpr int DM = 2048, NBATCH = 2, SEQ = 16384, MT = NBATCH * SEQ, DEPTH = 4, NMEM = 256, DFF = 5632;
constexpr int NIN = 14092, NP = 6144;
constexpr int C_HQ = 0, C_HF = 512, C_HI = 1024, C_HG = 1536, C_DQ = 2048, C_DK = 2560, C_DV = 3072, C_NQ = 3584,
              C_KC = 4096, C_VC = 4224, C_KS = 4352, C_VS = 4480, C_KW = 4608, C_VW = 4736, C_GZ = 4864, C_NG = 5888;
constexpr int NTHREADS = 512, LDS_BYTES = 163840 - 512;
constexpr int LDS_BARW = LDS_BYTES - 64;

constexpr size_t MiB = 1ull << 20;
constexpr size_t WS_CTL  = 0;
constexpr size_t WS_TAB  = 65536;
constexpr size_t TAB_LB = 0, TAB_LAM = 8192, TAB_CBIAS = 8448;
constexpr size_t WS_H    = 131072;
constexpr size_t WS_P    = WS_H + 128 * MiB;
constexpr size_t WS_CK   = WS_P + 384 * MiB;
constexpr size_t CKV_BYTES = (size_t)(MT + 64) * 128 * 2;
constexpr size_t WS_CV   = WS_CK + CKV_BYTES;
constexpr size_t WS_HC   = WS_CV + CKV_BYTES;
constexpr size_t WS_KC   = WS_HC + 2 * MiB;
constexpr size_t WS_VC   = WS_KC + 512 * 1024;
constexpr size_t WS_OALL = WS_VC + 512 * 1024;
constexpr size_t WS_HST  = WS_OALL + 128 * MiB;
constexpr size_t WS_HD   = WS_HST + 128 * MiB;
constexpr size_t WS_PSUM = WS_HD + 1 * MiB;
constexpr size_t WS_SEL  = WS_PSUM + 128 * MiB;
constexpr size_t WS_NACC = WS_SEL + 1 * MiB;
constexpr size_t WS_GSCR = WS_NACC + 64 * MiB;
constexpr size_t WS_MACC = WS_GSCR + 32 * MiB;
constexpr size_t WS_WIN  = WS_MACC + 64 * MiB;
constexpr size_t WS_WG   = WS_WIN + 96 * MiB;
constexpr float GATE_WSCALE = 64.f;
constexpr float XA_PSCALE = 256.f;
constexpr size_t WS_WB   = WS_WG + 128 * MiB;
constexpr size_t WS_WO   = WS_WB + 32 * MiB;
constexpr size_t WS_WQK  = WS_WO + 32 * MiB;
constexpr size_t WS_VWO  = WS_WQK + 32 * MiB;
constexpr size_t WS_FF1  = WS_VWO + 32 * MiB;
constexpr size_t WS_FF2  = WS_FF1 + 176 * MiB;
constexpr size_t WS_CW1  = WS_FF2 + 88 * MiB;
constexpr size_t WS_GMW  = WS_CW1 + 16 * MiB;
constexpr size_t WS_CW2  = WS_GMW + 512 * 1024;
constexpr size_t WS_SS   = WS_GMW + 1 * MiB;
constexpr size_t WS_END  = WS_SS + 1 * MiB;
constexpr size_t WS_WQB  = WS_P;
constexpr size_t WS_WOT  = WS_P + 32 * MiB;
constexpr size_t WS_WKVT = WS_P + 64 * MiB;
constexpr size_t WS_MEMN = WS_P + 128 * MiB;
constexpr size_t WS_KV   = WS_P + 130 * MiB;
constexpr size_t WS_MRG  = WS_P;
constexpr size_t WS_GS4  = WS_P + 128 * MiB;
constexpr size_t WS_S    = WS_P + 128 * MiB;
constexpr size_t WS_PXA  = WS_P + 256 * MiB;
constexpr size_t WS_HID  = WS_P;

#define XB_TMO      128
#define XB_XCNT(j)  (256  + 64 * (j))
#define XB_XSUB(j)  (1280 + 64 * (j))
#define XB_XGEN(j)  (2304 + 64 * (j))
#define XB_TOP      3328
#define XB_TOPGEN   3392
#define XCD_BAR_WORDS 3456
#define XB_SPIN_CAP (1u << 18)
__device__ __forceinline__ unsigned xb_ld(unsigned* p)              { return __hip_atomic_load(p, __ATOMIC_RELAXED, __HIP_MEMORY_SCOPE_AGENT); }
__device__ __forceinline__ unsigned xb_add(unsigned* p, unsigned v) { return __hip_atomic_fetch_add(p, v, __ATOMIC_RELAXED, __HIP_MEMORY_SCOPE_AGENT); }
__device__ __forceinline__ unsigned xb_xcc_id() { return (unsigned)__builtin_amdgcn_s_getreg((3 << 11) | 20) & 0xFu; }
#define XB_SPIN(cond, bar) do { unsigned _sp = 0; while (cond) { __builtin_amdgcn_s_sleep(1); \
    if ((++_sp & 255u) == 0u) { if (xb_ld(&(bar)[XB_TMO])) break; if (_sp > XB_SPIN_CAP) { atomicAdd(&(bar)[XB_TMO], 1u); break; } } } } while (0)
__device__ __forceinline__ int lane_id() { return (int)__builtin_amdgcn_mbcnt_hi(~0u, __builtin_amdgcn_mbcnt_lo(~0u, 0u)); }
struct XcdBarrier { unsigned* bar; unsigned x; volatile LAS unsigned* st; int w0; };
__device__ __forceinline__ XcdBarrier xcd_barrier_post(unsigned* bar, volatile LAS unsigned* st, int w0) {
    XcdBarrier b; b.bar = bar; b.x = xb_xcc_id(); b.st = st; b.w0 = w0;
    if (w0 && lane_id() == 0) (void)xb_add(&bar[XB_XCNT(b.x)], 1u);
    return b;
}
__device__ __forceinline__ void xcd_barrier_complete(unsigned* bar, unsigned x, unsigned& nloc, unsigned& nx) {
    const unsigned G = gridDim.x * gridDim.y * gridDim.z;
    unsigned sum, cnt, mine, sp = 0u;
    for (;;) {
        sum = 0u; cnt = 0u; mine = 0u;
#pragma unroll
        for (unsigned j = 0; j < 16; ++j) { const unsigned c = xb_ld(&bar[XB_XCNT(j)]); sum += c; cnt += (c > 0u) ? 1u : 0u; mine = (j == x) ? c : mine; }
        if (sum == G) break;
        __builtin_amdgcn_s_sleep(1);
        if ((++sp & 255u) == 0u) { if (xb_ld(&bar[XB_TMO])) break; if (sp > XB_SPIN_CAP) { atomicAdd(&bar[XB_TMO], 1u); break; } }
    }
    nloc = mine > 0u ? mine : 1u; nx = cnt > 0u ? cnt : 1u;
}
__device__ __forceinline__ void xcd_barrier(const XcdBarrier& b) {
    asm volatile("s_waitcnt vmcnt(0)" ::: "memory");
    __syncthreads();
    if (b.w0 && lane_id() == 0) {
        unsigned* bar = b.bar;
        __builtin_amdgcn_s_waitcnt(0);
        unsigned nloc = b.st[0], nx = b.st[1];
        if (nloc == 0u) { xcd_barrier_complete(bar, b.x, nloc, nx); b.st[0] = nloc; b.st[1] = nx; }
        const unsigned old = xb_add(&bar[XB_XSUB(b.x)], 1u);
        const unsigned gen = old / nloc;
        if (old + 1u == (gen + 1u) * nloc) {
            __builtin_amdgcn_fence(__ATOMIC_RELEASE, "agent");
            asm volatile("s_waitcnt vmcnt(0)" ::: "memory");
            const unsigned og = xb_add(&bar[XB_TOP], 1u);
            const unsigned tg = og / nx;
            if (og + 1u == (tg + 1u) * nx) xb_add(&bar[XB_TOPGEN], 1u);
            else XB_SPIN(xb_ld(&bar[XB_TOPGEN]) == tg, bar);
            __builtin_amdgcn_fence(__ATOMIC_ACQUIRE, "agent");
            xb_add(&bar[XB_XGEN(b.x)], 1u);
            asm volatile("s_waitcnt vmcnt(0)" ::: "memory");
        } else {
            XB_SPIN(xb_ld(&bar[XB_XGEN(b.x)]) == gen, bar);
            __builtin_amdgcn_fence(__ATOMIC_ACQUIRE, "agent");
            asm volatile("s_waitcnt vmcnt(0)" ::: "memory");
        }
    }
    __syncthreads();
}

typedef __bf16 bf16x2_t __attribute__((ext_vector_type(2)));
__device__ __forceinline__ unsigned cvtpk(float lo, float hi) { const f32x2 v = {lo, hi}; return __builtin_bit_cast(unsigned, __builtin_convertvector(v, bf16x2_t)); }
__device__ __forceinline__ unsigned cvt4_fp8(float a, float b, float c, float d) {
    a = __builtin_amdgcn_fmed3f(a, -448.f, 448.f); b = __builtin_amdgcn_fmed3f(b, -448.f, 448.f); c = __builtin_amdgcn_fmed3f(c, -448.f, 448.f); d = __builtin_amdgcn_fmed3f(d, -448.f, 448.f);
    int w = __builtin_amdgcn_cvt_pk_fp8_f32(a, b, 0, false); w = __builtin_amdgcn_cvt_pk_fp8_f32(c, d, w, true); return (unsigned)w;
}
__device__ __forceinline__ bf16_t f2bf(float f) { return (bf16_t)(cvtpk(f, 0.f) & 0xFFFFu); }
__device__ __forceinline__ float bf2f(bf16_t b) { return __uint_as_float(((unsigned)b) << 16); }
__device__ __forceinline__ float bflo(unsigned w) { return __uint_as_float(w << 16); }
__device__ __forceinline__ float bfhi(unsigned w) { return __uint_as_float(w & 0xFFFF0000u); }
__device__ __forceinline__ float sigmoidf_(float x) { return __builtin_amdgcn_rcpf(1.f + __expf(-x)); }
__device__ __forceinline__ float siluf_(float x) { return x * __builtin_amdgcn_rcpf(1.f + __expf(-x)); }
__device__ __forceinline__ float gelu_tanh(float x) {
    const float u = 0.7978845608028654f * (x + 0.044715f * x * x * x);
    const float e = __expf(2.f * u);
    const float th = 1.f - 2.f * __builtin_amdgcn_rcpf(e + 1.f);
    return 0.5f * x * (1.f + th);
}
__device__ __forceinline__ float wave_sum(float v) {
#pragma unroll
    for (int o = 32; o >= 1; o >>= 1) v += __shfl_xor(v, o);
    return v;
}
__device__ __forceinline__ float wave_max(float v) {
#pragma unroll
    for (int o = 32; o >= 1; o >>= 1) v = fmaxf(v, __shfl_xor(v, o));
    return v;
}

#define GAS __attribute__((address_space(1)))
struct Frame {
    const float* const __attribute__((address_space(4)))* in;
    __device__ __forceinline__ const float* inp(int i) const { return (const float*)(const GAS float*)in[i]; }
    float* out;
    unsigned char* ws;
    LAS unsigned char* lds;
    int tid, lane, wave, G, wg;
};
namespace pg8 {
constexpr int BM = 256, BK = 64, HALF = 128, HTB = HALF * BK * 2, STAGE_BYTES = 8 * HTB, NXCD = 8, WGM = 8;
__host__ __device__ __forceinline__ int lds_byte(int r, int c) { const int st = (r >> 4) * 2 + (c >> 5), rr = r & 15, cc = c & 31, ob = rr * 64 + cc * 2; return st * 1024 + (ob ^ (((ob >> 9) & 1) << 5)); }
__host__ __device__ __forceinline__ void stage_rc(int b, int& R, int& C) { const int st = b / 1024, sb = b % 1024, swz = sb ^ (((sb >> 9) & 1) << 5); R = (st >> 1) * 16 + swz / 64; C = (st & 1) * 32 + (swz % 64) / 2; }
__host__ __device__ __forceinline__ int perm32(int rho) { const int n = rho >> 4, i = rho & 15; return 8 * (i >> 2) + 4 * n + (i & 3); }

struct GUnit { const char* A; const char* B; int nt; int pm, pn, aux; };

__device__ __forceinline__ void tile_map(int L, int nM, int nN, int& tm, int& tn) {
    const int nwg = nM * nN; int wgid = L;
    { const int q = nwg / NXCD, r = nwg % NXCD, xcd = wgid % NXCD, off = wgid / NXCD; wgid = (xcd < r ? xcd * (q + 1) : r * (q + 1) + (xcd - r) * q) + off; }
    const int nig = WGM * nN, gid = wgid / nig, fm = gid * WGM, gsz = (nM - fm) < WGM ? (nM - fm) : WGM;
    tm = fm + ((wgid % nig) % gsz); tn = (wgid % nig) / gsz;
}

template <class Epi, class Sched>
__device__ __forceinline__ void gemm_phase(LAS unsigned char* lds, const int tid, const Sched S, const Epi E) {
    const int wid = __builtin_amdgcn_readfirstlane(tid >> 6), lane = tid & 63, wr = wid >> 2, wc = wid & 3, fr = lane & 15, fq = lane >> 4;
    unsigned voffA[2], voffB[2];
#pragma unroll
    for (int i = 0; i < 2; ++i) { int R, C; stage_rc(tid * 16 + i * 8192, R, C); const int Rb = Epi::PERM ? ((R & ~31) + perm32(R & 31)) : R;
        voffA[i] = (unsigned)(R * (int)S.lda + C) * 2u; voffB[i] = (unsigned)(Rb * (int)S.ldb + C) * 2u; }
    const size_t kstep = (size_t)(BK * 2);
    const size_t hstepA = (size_t)HALF * S.lda * 2, hstepB = (size_t)HALF * S.ldb * 2;
    const unsigned ldsm0 = (unsigned)__builtin_amdgcn_readfirstlane((int)((unsigned)(size_t)lds + (unsigned)wid * 1024u));
    const int aoff = lds_byte(wr * 64 + fr, fq * 8), boff = lds_byte(wc * 32 + fr, fq * 8);
#define PG8_SA(b, h) (((b) * 2 + (h)) * HTB)
#define PG8_SB(b, h) ((4 + (b) * 2 + (h)) * HTB)
#define PG8_STAGE(bufoff, gbase, voff) do { _Pragma("unroll") for (int _i = 0; _i < 2; ++_i) \
        asm volatile("s_mov_b32 m0, %0\n\tglobal_load_lds_dwordx4 %1, %2" :: "s"(ldsm0 + (unsigned)((bufoff) + _i * 8192)), "v"((voff)[_i]), "s"((const char*)(gbase)) : "memory"); } while (0)
#define PG8_LDA(dst, b, h) do { _Pragma("unroll") for (int m = 0; m < 4; ++m) _Pragma("unroll") for (int k = 0; k < 2; ++k) dst[m][k] = *(const LAS bf16x8*)(lds + PG8_SA(b, h) + aoff + m * 2048 + k * 1024); } while (0)
#define PG8_LDB(dst, b, h) do { _Pragma("unroll") for (int n = 0; n < 2; ++n) _Pragma("unroll") for (int k = 0; k < 2; ++k) dst[n][k] = *(const LAS bf16x8*)(lds + PG8_SB(b, h) + boff + n * 2048 + k * 1024); } while (0)
#define PG8_MMA(ai, bj, At, Bt) do { __builtin_amdgcn_s_setprio(1); _Pragma("unroll") for (int m = 0; m < 4; ++m) _Pragma("unroll") for (int n = 0; n < 2; ++n) _Pragma("unroll") for (int k = 0; k < 2; ++k) \
        acc[ai][bj][m][n] = __builtin_amdgcn_mfma_f32_16x16x32_bf16(Bt[n][k], At[m][k], acc[ai][bj][m][n], 0, 0, 0); __builtin_amdgcn_s_setprio(0); } while (0)
#define PG8_LDA8(dst, b, h) do { _Pragma("unroll") for (int m = 0; m < 4; ++m) { const i32x4 lo_ = *(const LAS i32x4*)(lds + PG8_SA(b, h) + aoff + m * 2048), hi_ = *(const LAS i32x4*)(lds + PG8_SA(b, h) + aoff + m * 2048 + 1024); \
        dst[m] = __builtin_shufflevector(lo_, hi_, 0, 1, 2, 3, 4, 5, 6, 7); } } while (0)
#define PG8_LDB8(dst, b, h) do { _Pragma("unroll") for (int n = 0; n < 2; ++n) { const i32x4 lo_ = *(const LAS i32x4*)(lds + PG8_SB(b, h) + boff + n * 2048), hi_ = *(const LAS i32x4*)(lds + PG8_SB(b, h) + boff + n * 2048 + 1024); \
        dst[n] = __builtin_shufflevector(lo_, hi_, 0, 1, 2, 3, 4, 5, 6, 7); } } while (0)
#define PG8_MMA8(ai, bj, At, Bt) do { __builtin_amdgcn_s_setprio(1); _Pragma("unroll") for (int m = 0; m < 4; ++m) _Pragma("unroll") for (int n = 0; n < 2; ++n) \
        asm volatile("v_mfma_f32_16x16x128_f8f6f4 %0, %1, %2, %0" : "+v"(acc[ai][bj][m][n]) : "v"(Bt[n]), "v"(At[m])); __builtin_amdgcn_s_setprio(0); } while (0)
#define PG8_MFMA_DRAIN asm volatile("s_nop 15\n\ts_nop 15" ::: "memory")
#define PG8_WAIT_V(n) asm volatile("s_waitcnt vmcnt(" #n ")" ::: "memory")
#define PG8_WAIT_L(n) asm volatile("s_waitcnt lgkmcnt(" #n ")" ::: "memory")
#define PG8_BAR __builtin_amdgcn_s_barrier()
#define PG8_SCHED __builtin_amdgcn_sched_barrier(0)
    GUnit cur, nxt; int ui = 0;
    if (!S.next(0, cur)) return;
    f32x4 acc[2][2][4][2];
#pragma unroll
    for (int a = 0; a < 2; ++a)
#pragma unroll
        for (int b = 0; b < 2; ++b)
#pragma unroll
            for (int m = 0; m < 4; ++m)
#pragma unroll
                for (int n = 0; n < 2; ++n) acc[a][b][m][n] = (f32x4){0.f, 0.f, 0.f, 0.f};
    bf16x8 At[4][2], B0[2][2], B1[2][2];
    u32x4 keep[8];
    const char* cA = cur.A; const char* cB = cur.B;
    f32x4 ssa, ssb;
    E.preload(cur, tid, ssa, ssb); E.finish(cur, tid, 0, ssa, ssb);
    PG8_STAGE(PG8_SB(0, 0), cB, voffB); PG8_STAGE(PG8_SB(0, 1), cB + hstepB, voffB); PG8_STAGE(PG8_SA(0, 0), cA, voffA); PG8_STAGE(PG8_SA(0, 1), cA + hstepA, voffA);
    if (wr == 1) PG8_BAR;
    PG8_WAIT_V(2); PG8_BAR;
    PG8_STAGE(PG8_SB(1, 0), cB + kstep, voffB); PG8_STAGE(PG8_SA(1, 0), cA + kstep, voffA); PG8_STAGE(PG8_SB(1, 1), cB + hstepB + kstep, voffB);
    PG8_WAIT_V(6); PG8_BAR;
    for (;;) {
        const bool has_next = S.next(ui + 1, nxt);
        const char* nA = has_next ? nxt.A : cA; const char* nB = has_next ? nxt.B : cB;
        const int nt = cur.nt;
#define PG8_KLOOP(LDA, LDB, MMA, At, B0, B1) \
        for (int t = 0; t < nt; t += 2) { \
            const bool last = (t == nt - 2); \
            const char* a1 = cA + (size_t)(t + 1) * kstep; \
            const char* a2 = last ? nA : cA + (size_t)(t + 2) * kstep; const char* b2 = last ? nB : cB + (size_t)(t + 2) * kstep; \
            const char* a3 = a2 + kstep; const char* b3 = b2 + kstep; \
            LDB(B0, 0, 0); LDB(B1, 0, 1); PG8_SCHED; LDA(At, 0, 0); PG8_STAGE(PG8_SA(1, 1), a1 + hstepA, voffA); \
            PG8_WAIT_V(8); PG8_WAIT_L(0); PG8_BAR; MMA(0, 0, At, B0); MMA(0, 1, At, B1); PG8_BAR; PG8_SCHED; \
            LDA(At, 0, 1); PG8_STAGE(PG8_SB(0, 0), b2, voffB); PG8_STAGE(PG8_SB(0, 1), b2 + hstepB, voffB); PG8_STAGE(PG8_SA(0, 0), a2, voffA); \
            PG8_WAIT_V(8); PG8_WAIT_L(0); PG8_BAR; MMA(1, 0, At, B0); MMA(1, 1, At, B1); PG8_BAR; PG8_SCHED; \
            LDB(B0, 1, 0); LDB(B1, 1, 1); PG8_SCHED; LDA(At, 1, 0); PG8_STAGE(PG8_SA(0, 1), a2 + hstepA, voffA); \
            PG8_WAIT_V(8); PG8_WAIT_L(0); PG8_BAR; MMA(0, 0, At, B0); MMA(0, 1, At, B1); PG8_BAR; PG8_SCHED; \
            LDA(At, 1, 1); PG8_STAGE(PG8_SB(1, 0), b3, voffB); PG8_STAGE(PG8_SB(1, 1), b3 + hstepB, voffB); PG8_STAGE(PG8_SA(1, 0), a3, voffA); \
            PG8_WAIT_V(8); PG8_WAIT_L(0); PG8_BAR; MMA(1, 0, At, B0); MMA(1, 1, At, B1); PG8_BAR; PG8_SCHED; \
        }
        if (Sched::F8 && (cur.aux & 1) == 0) { i32x8 A8[4], B80[2], B81[2]; PG8_KLOOP(PG8_LDA8, PG8_LDB8, PG8_MMA8, A8, B80, B81) PG8_MFMA_DRAIN; }
        else { PG8_KLOOP(PG8_LDA, PG8_LDB, PG8_MMA, At, B0, B1) }
#undef PG8_KLOOP
        if (wr == 0) PG8_BAR;
        { int fr_ = fr, fq_ = fq, tid_ = tid; asm volatile("" : "+v"(fr_), "+v"(fq_), "+v"(tid_));
          if (has_next) E.preload(nxt, tid_, ssa, ssb);
          E(acc, keep, cur, ui, tid_, wr, wc, fr_, fq_); }
        if (!has_next) break;
#pragma unroll
        for (int a = 0; a < 2; ++a)
#pragma unroll
            for (int b = 0; b < 2; ++b)
#pragma unroll
                for (int m = 0; m < 4; ++m)
#pragma unroll
                    for (int n = 0; n < 2; ++n) acc[a][b][m][n] = (f32x4){0.f, 0.f, 0.f, 0.f};
        cur = nxt; cA = nA; cB = nB; ++ui;
        E.finish(cur, tid, ui, ssa, ssb);
        if (wr == 1) PG8_BAR;
    }
    PG8_WAIT_V(0);
    PG8_BAR;
#undef PG8_SA
#undef PG8_SB
#undef PG8_STAGE
#undef PG8_LDA
#undef PG8_LDB
#undef PG8_MMA
#undef PG8_LDA8
#undef PG8_LDB8
#undef PG8_MMA8
#undef PG8_MFMA_DRAIN
#undef PG8_WAIT_V
#undef PG8_WAIT_L
#undef PG8_BAR
#undef PG8_SCHED
}

struct SchedStd {
    static constexpr bool F8 = false;
    int nM, nN, G, c, nt; unsigned lda, ldb; const char* A; const char* B; size_t bBatch;
    __device__ __forceinline__ bool next(int i, GUnit& u) const {
        const long L = (long)i * G + c; if (L >= (long)nM * nN) return false;
        int tm, tn; tile_map((int)L, nM, nN, tm, tn);
        u.A = A + (size_t)tm * 256 * lda * 2; u.B = B + (size_t)tn * 256 * ldb * 2 + ((bBatch && tm >= nM / 2) ? bBatch : 0);
        u.nt = nt; u.pm = tm * 256; u.pn = tn * 256; u.aux = 0; return true;
    }
};
struct SchedStd8 {
    static constexpr bool F8 = true;
    int nM, nN, G, c, nt; unsigned lda, ldb; const char* A; const char* B; size_t bBatch;
    __device__ __forceinline__ bool next(int i, GUnit& u) const {
        const long L = (long)i * G + c; if (L >= (long)nM * nN) return false;
        int tm, tn; tile_map((int)L, nM, nN, tm, tn);
        u.A = A + (size_t)tm * 256 * lda * 2; u.B = B + (size_t)tn * 256 * ldb * 2 + ((bBatch && tm >= nM / 2) ? bBatch : 0);
        u.nt = nt; u.pm = tm * 256; u.pn = tn * 256; u.aux = 0; return true;
    }
};
struct SchedMerge {
    static constexpr bool F8 = true;
    int G, c; unsigned lda, ldb; const char* H; const char* O; const char* WG; const char* WB;
    __device__ __forceinline__ bool next(int i, GUnit& u) const {
        const long T = (long)(i >> 3) * G + c; if (T >= 128 * 8) return false;
        const int sub = i & 7, b = sub >> 1, kind = sub & 1;
        int tm, tn; tile_map((int)T, 128, 8, tm, tn);
        if (kind == 0) { u.A = H + (size_t)tm * 256 * 2048 * 2; u.B = WG + ((size_t)b * 2048 + tn * 256) * 2048 * 2; u.nt = 16; }
        else           { u.A = O + (size_t)tm * 256 * 2048 * 2 + b * 512 * 2; u.B = WB + (size_t)tn * 256 * 2048 * 2 + b * 512 * 2; u.nt = 8; }
        u.pm = tm * 256; u.pn = tn * 256; u.aux = sub; return true;
    }
};
struct SchedKV {
    static constexpr bool F8 = false;
    int G, c; unsigned lda, ldb; const char* A; const char* B;
    __device__ __forceinline__ bool next(int i, GUnit& u) const {
        const int L = i * G + c; if (L >= 128) return false;
        const int tm = L & 1, tn = (L >> 1) & 15, l = L >> 5;
        u.A = A + (size_t)tm * (256u * 2048 * 2); u.B = B + (size_t)l * (4096u * 2048 * 2) + (size_t)tn * (256u * 2048 * 2);
        u.pm = l * 512 + tm * 256; u.pn = tn * 256; u.nt = 32; u.aux = 0; return true;
    }
};
struct SchedWQK {
    static constexpr bool F8 = false;
    int G, c; unsigned lda, ldb; const char* A; const char* B;
    __device__ __forceinline__ bool next(int i, GUnit& u) const {
        const int L = i * G + c; if (L >= 256) return false;
        const int tn = L & 7, h = (L >> 3) & 3, b = (L >> 5) & 1, l = L >> 6;
        u.A = A + (size_t)l * (512u * 4096 * 2) + (size_t)b * (256u * 4096 * 2) + h * 1024;
        u.B = B + (size_t)l * (2048u * 2048 * 2) + (size_t)tn * (256u * 2048 * 2) + h * 1024;
        u.pm = l * 2048 + b * 1024 + h * 256; u.pn = tn * 256; u.nt = 8; u.aux = 0; return true;
    }
};
struct SchedVWO {
    static constexpr bool F8 = false;
    int G, c; unsigned lda, ldb; const char* A; const char* B;
    __device__ __forceinline__ bool next(int i, GUnit& u) const {
        const int L = i * G + c; if (L >= 256) return false;
        const int tm = L & 7, h = (L >> 3) & 3, b = (L >> 5) & 1, l = L >> 6;
        u.A = A + (size_t)l * (2048u * 2048 * 2) + (size_t)tm * (256u * 2048 * 2) + h * 1024;
        u.B = B + (size_t)l * (512u * 4096 * 2) + (size_t)b * (256u * 4096 * 2) + 4096 + h * 1024;
        u.pm = l * 4096 + b * 2048 + tm * 256; u.pn = h * 256; u.nt = 8; u.aux = 0; return true;
    }
};
struct SchedCmpOne {
    static constexpr bool F8 = false;
    int L; unsigned lda, ldb; const char* A; const char* B;
    __device__ __forceinline__ bool next(int i, GUnit& u) const {
        if (i != 0) return false;
        const int tm = L & 7, kv = L >> 3;
        u.A = A + (size_t)kv * CKV_BYTES + (size_t)tm * (256u * 2048 * 2); u.B = B + (size_t)kv * (256u * 4096 * 2);
        u.pm = kv * 2048 + tm * 256; u.pn = 0; u.nt = 64; u.aux = kv; return true;
    }
};
struct SchedCmp {
    static constexpr bool F8 = false;
    int G, c; unsigned lda, ldb; const char* A; const char* B;
    __device__ __forceinline__ bool next(int i, GUnit& u) const {
        const int L = i * G + c; if (L >= 16) return false;
        const int tm = L & 7, kv = L >> 3;
        u.A = A + (size_t)kv * CKV_BYTES + (size_t)tm * (256u * 2048 * 2); u.B = B + (size_t)kv * (256u * 4096 * 2);
        u.pm = kv * 2048 + tm * 256; u.pn = 0; u.nt = 64; u.aux = kv; return true;
    }
};

#define EPI_ARGS const f32x4 (&acc)[2][2][4][2], u32x4 (&keep)[8], const GUnit& u, int ui, int tid, int wr, int wc, int fr, int fq
#define EPI_NOBEGIN __device__ __forceinline__ void preload(const GUnit&, int, f32x4&, f32x4&) const {} __device__ __forceinline__ void finish(const GUnit&, int, int, const f32x4&, const f32x4&) const {}
constexpr int RSBUF_OFF = 131072 + 4096;
__device__ __forceinline__ void rs_preload(const float* SS, const GUnit& u, int tid, f32x4& a, f32x4& b) {
    if (tid < 256) { const float* sp = SS + (size_t)(u.pm + tid) * 8; a = *(const f32x4*)sp; b = *(const f32x4*)(sp + 4); }
}
__device__ __forceinline__ void rs_finish(LAS unsigned char* lds, int tid, int ui, const f32x4& a, const f32x4& b) {
    if (tid < 256) ((LAS float*)(lds + RSBUF_OFF))[(ui & 1) * 256 + tid] = rsqrtf((((a[0] + a[1]) + (a[2] + a[3])) + ((b[0] + b[1]) + (b[2] + b[3]))) * (1.f / 2048.f) + 1e-6f);
}
__device__ __forceinline__ void rs_get(LAS unsigned char* lds, int ui, int wr, int fr, float (&rs)[2][4]) {
#pragma unroll
    for (int ai = 0; ai < 2; ++ai)
#pragma unroll
        for (int m = 0; m < 4; ++m) rs[ai][m] = ((const LAS float*)(lds + RSBUF_OFF))[(ui & 1) * 256 + ai * HALF + wr * 64 + m * 16 + fr];
}
struct EpiGen {
    static constexpr bool PERM = true;
    bf16_t* O; const float* bias; int ldc, mode; float scale; int pad_;
    EPI_NOBEGIN
    __device__ __forceinline__ void operator()(EPI_ARGS) const {
        const int row0 = u.pm + wr * 64 + fr, colt = wc * 32 + 8 * fq;
#pragma unroll
        for (int bj = 0; bj < 2; ++bj) {
            f32x4 bv0 = (f32x4){0.f, 0.f, 0.f, 0.f}, bv1 = bv0;
            if (mode == 1) { const float* bp = bias + u.aux * 256 + colt + bj * HALF; bv0 = *(const f32x4*)bp; bv1 = *(const f32x4*)(bp + 4); }
#pragma unroll
            for (int ai = 0; ai < 2; ++ai)
#pragma unroll
                for (int m = 0; m < 4; ++m) {
                    f32x4 v0 = acc[ai][bj][m][0] * scale + bv0, v1 = acc[ai][bj][m][1] * scale + bv1;
                    if (mode == 1) {
#pragma unroll
                        for (int e = 0; e < 4; ++e) { v0[e] = siluf_(v0[e]); v1[e] = siluf_(v1[e]); }
                    }
                    if (mode == 2) {
                        *(u32x2*)((unsigned char*)O + (size_t)(row0 + ai * HALF + m * 16) * ldc + u.pn + colt + bj * HALF) = (u32x2){cvt4_fp8(v0[0], v0[1], v0[2], v0[3]), cvt4_fp8(v1[0], v1[1], v1[2], v1[3])};
                    } else {
                    bf16_t* p = O + (size_t)(row0 + ai * HALF + m * 16) * ldc + u.pn + colt + bj * HALF;
                    *(u32x4*)p = (u32x4){cvtpk(v0[0], v0[1]), cvtpk(v0[2], v0[3]), cvtpk(v1[0], v1[1]), cvtpk(v1[2], v1[3])}; }
                }
        }
    }
};
struct EpiInProj {
    static constexpr bool PERM = true;
    bf16_t* P; bf16_t* CK; bf16_t* CV; const float* SS; LAS unsigned char* lds;
    __device__ __forceinline__ void preload(const GUnit& u, int tid, f32x4& a, f32x4& b) const { rs_preload(SS, u, tid, a, b); }
    __device__ __forceinline__ void finish(const GUnit&, int tid, int ui, const f32x4& a, const f32x4& b) const { rs_finish(lds, tid, ui, a, b); }
    __device__ __forceinline__ void operator()(EPI_ARGS) const {
        const int row0 = u.pm + wr * 64 + fr, colt = wc * 32 + 8 * fq;
        const bool ckv = (u.pn == C_KC);
        float rs[2][4]; rs_get(lds, ui, wr, fr, rs);
#pragma unroll
        for (int bj = 0; bj < 2; ++bj) {
            bf16_t* base; size_t ld;
            if (ckv) { base = (bj ? CV : CK) + colt; ld = 128; } else { base = P + u.pn + colt + bj * HALF; ld = NP; }
#pragma unroll
            for (int ai = 0; ai < 2; ++ai)
#pragma unroll
                for (int m = 0; m < 4; ++m) {
                    const f32x4 v0 = acc[ai][bj][m][0] * rs[ai][m], v1 = acc[ai][bj][m][1] * rs[ai][m];
                    *(u32x4*)(base + (size_t)(row0 + ai * HALF + m * 16) * ld) = (u32x4){cvtpk(v0[0], v0[1]), cvtpk(v0[2], v0[3]), cvtpk(v1[0], v1[1]), cvtpk(v1[2], v1[3])};
                }
        }
    }
};
struct EpiFfn1 {
    static constexpr bool PERM = true;
    bf16_t* Hd; const float* SS; LAS unsigned char* lds;
    __device__ __forceinline__ void preload(const GUnit& u, int tid, f32x4& a, f32x4& b) const { rs_preload(SS, u, tid, a, b); }
    __device__ __forceinline__ void finish(const GUnit&, int tid, int ui, const f32x4& a, const f32x4& b) const { rs_finish(lds, tid, ui, a, b); }
    __device__ __forceinline__ void operator()(EPI_ARGS) const {
        const int row0 = u.pm + wr * 64 + fr, col0 = (u.pn >> 1) + wc * 32 + 8 * fq;
        float rs[2][4]; rs_get(lds, ui, wr, fr, rs);
#pragma unroll
        for (int ai = 0; ai < 2; ++ai)
#pragma unroll
            for (int m = 0; m < 4; ++m) {
                float r[8];
#pragma unroll
                for (int n = 0; n < 2; ++n)
#pragma unroll
                    for (int e = 0; e < 4; ++e) r[n * 4 + e] = siluf_(acc[ai][0][m][n][e] * rs[ai][m]) * (acc[ai][1][m][n][e] * rs[ai][m]);
                *(u32x4*)(Hd + (size_t)(row0 + ai * HALF + m * 16) * DFF + col0) = (u32x4){cvtpk(r[0], r[1]), cvtpk(r[2], r[3]), cvtpk(r[4], r[5]), cvtpk(r[6], r[7])};
            }
    }
};
struct EpiResid {
    static constexpr bool PERM = true;
    bf16_t* XH; float* SS; LAS float* red; unsigned char* X8; float sc; int pad_;
    EPI_NOBEGIN
    __device__ __forceinline__ void operator()(EPI_ARGS) const {
        const int row0 = u.pm + wr * 64 + fr, col0 = u.pn + wc * 32 + 8 * fq;
        u32x4 xh[2][4][2];
#pragma unroll
        for (int ai = 0; ai < 2; ++ai)
#pragma unroll
            for (int m = 0; m < 4; ++m)
#pragma unroll
                for (int bj = 0; bj < 2; ++bj) xh[ai][m][bj] = *(const u32x4*)(XH + (size_t)(row0 + ai * HALF + m * 16) * DM + col0 + bj * HALF);
#pragma unroll
        for (int ai = 0; ai < 2; ++ai)
#pragma unroll
            for (int m = 0; m < 4; ++m) { const size_t ro = (size_t)(row0 + ai * HALF + m * 16) * DM + col0; float ss = 0.f;
#pragma unroll
                for (int bj = 0; bj < 2; ++bj) { const size_t o = ro + bj * HALF; float v[8]; unsigned hw[4]; const u32x4 ph = xh[ai][m][bj];
#pragma unroll
                    for (int j = 0; j < 4; ++j) { v[2 * j] = bflo(ph[j]) + acc[ai][bj][m][j >> 1][(2 * j) & 3] * sc; v[2 * j + 1] = bfhi(ph[j]) + acc[ai][bj][m][j >> 1][(2 * j + 1) & 3] * sc; }
#pragma unroll
                    for (int j = 0; j < 4; ++j) { hw[j] = cvtpk(v[2 * j], v[2 * j + 1]); const float r0 = bflo(hw[j]), r1 = bfhi(hw[j]); ss += r0 * r0 + r1 * r1; }
                    *(u32x4*)(XH + o) = (u32x4){hw[0], hw[1], hw[2], hw[3]};
                    if (X8) *(u32x2*)(X8 + (size_t)(row0 + ai * HALF + m * 16) * 4096 + col0 + bj * HALF) = (u32x2){cvt4_fp8(v[0], v[1], v[2], v[3]), cvt4_fp8(v[4], v[5], v[6], v[7])}; }
                ss += __shfl_xor(ss, 16); ss += __shfl_xor(ss, 32);
                if (fq == 0) red[wc * 256 + ai * HALF + wr * 64 + m * 16 + fr] = ss; }
        asm volatile("s_waitcnt lgkmcnt(0)" ::: "memory"); __builtin_amdgcn_s_barrier();
        if (tid < 256) SS[(size_t)(u.pm + tid) * 8 + (u.pn >> 8)] = (red[tid] + red[256 + tid]) + (red[512 + tid] + red[768 + tid]);
        asm volatile("s_waitcnt lgkmcnt(0)" ::: "memory"); __builtin_amdgcn_s_barrier();
    }
};
struct EpiF32 {
    static constexpr bool PERM = false;
    float* C; const float* SS; LAS unsigned char* lds; int ldc, pad_;
    __device__ __forceinline__ void preload(const GUnit& u, int tid, f32x4& a, f32x4& b) const { rs_preload(SS, u, tid, a, b); }
    __device__ __forceinline__ void finish(const GUnit&, int tid, int ui, const f32x4& a, const f32x4& b) const { rs_finish(lds, tid, ui, a, b); }
    __device__ __forceinline__ void operator()(EPI_ARGS) const {
        const int row0 = u.pm + wr * 64 + fr, col0 = u.pn + wc * 32 + 4 * fq;
        float rs[2][4]; rs_get(lds, ui, wr, fr, rs);
#pragma unroll
        for (int ai = 0; ai < 2; ++ai)
#pragma unroll
            for (int m = 0; m < 4; ++m) { float* rp = C + (size_t)(row0 + ai * HALF + m * 16) * ldc + col0;
#pragma unroll
                for (int bj = 0; bj < 2; ++bj)
#pragma unroll
                    for (int n = 0; n < 2; ++n) *(f32x4*)(rp + bj * HALF + n * 16) = acc[ai][bj][m][n] * rs[ai][m]; }
    }
};
struct EpiXaSoftmax {
    static constexpr bool PERM = true;
    bf16_t* Pq; const float* SS; LAS unsigned char* lds;
    __device__ __forceinline__ void preload(const GUnit& u, int tid, f32x4& a, f32x4& b) const { rs_preload(SS, u, tid, a, b); }
    __device__ __forceinline__ void finish(const GUnit&, int tid, int ui, const f32x4& a, const f32x4& b) const { rs_finish(lds, tid, ui, a, b); }
    __device__ __forceinline__ void operator()(EPI_ARGS) const {
        LAS float* redm = (LAS float*)(lds + 131072); LAS float* reds = (LAS float*)(lds + 131072 + 8192);
        const int row0 = u.pm + wr * 64 + fr, col0 = u.pn + wc * 32 + 8 * fq;
        float rs[2][4]; rs_get(lds, ui, wr, fr, rs);
#pragma unroll
        for (int ai = 0; ai < 2; ++ai)
#pragma unroll
            for (int m = 0; m < 4; ++m) rs[ai][m] *= (1.f / GATE_WSCALE);
        float mx[2][4];
#pragma unroll
        for (int ai = 0; ai < 2; ++ai)
#pragma unroll
            for (int m = 0; m < 4; ++m) { float v = -3.0e38f;
#pragma unroll
                for (int bj = 0; bj < 2; ++bj)
#pragma unroll
                    for (int n = 0; n < 2; ++n)
#pragma unroll
                        for (int e = 0; e < 4; ++e) v = fmaxf(v, acc[ai][bj][m][n][e]);
                v = fmaxf(v, __shfl_xor(v, 16)); v = fmaxf(v, __shfl_xor(v, 32));
                if (fq == 0) redm[wc * 256 + ai * HALF + wr * 64 + m * 16 + fr] = v; }
        asm volatile("s_waitcnt lgkmcnt(0)" ::: "memory"); __builtin_amdgcn_s_barrier();
        float ex[2][4][2][2][4];
#pragma unroll
        for (int ai = 0; ai < 2; ++ai)
#pragma unroll
            for (int m = 0; m < 4; ++m) { const int rl = ai * HALF + wr * 64 + m * 16 + fr;
                const float mm = fmaxf(fmaxf(redm[rl], redm[256 + rl]), fmaxf(redm[512 + rl], redm[768 + rl])) * rs[ai][m];
                mx[ai][m] = mm; float sum = 0.f;
#pragma unroll
                for (int bj = 0; bj < 2; ++bj)
#pragma unroll
                    for (int n = 0; n < 2; ++n)
#pragma unroll
                        for (int e = 0; e < 4; ++e) { const float x = __expf(acc[ai][bj][m][n][e] * rs[ai][m] - mm); ex[ai][m][bj][n][e] = x; sum += x; }
                sum += __shfl_xor(sum, 16); sum += __shfl_xor(sum, 32);
                if (fq == 0) reds[wc * 256 + rl] = sum; }
        asm volatile("s_waitcnt lgkmcnt(0)" ::: "memory"); __builtin_amdgcn_s_barrier();
#pragma unroll
        for (int ai = 0; ai < 2; ++ai)
#pragma unroll
            for (int m = 0; m < 4; ++m) { const int rl = ai * HALF + wr * 64 + m * 16 + fr;
                const float inv = XA_PSCALE / ((reds[rl] + reds[256 + rl]) + (reds[512 + rl] + reds[768 + rl]));
#pragma unroll
                for (int bj = 0; bj < 2; ++bj) { const float* x = &ex[ai][m][bj][0][0];
                    *(u32x2*)((unsigned char*)Pq + (size_t)(row0 + ai * HALF + m * 16) * 1024 + col0 + bj * HALF) =
                        (u32x2){cvt4_fp8(x[0] * inv, x[1] * inv, x[2] * inv, x[3] * inv), cvt4_fp8(x[4] * inv, x[5] * inv, x[6] * inv, x[7] * inv)}; } }
        (void)mx;
        asm volatile("s_waitcnt lgkmcnt(0)" ::: "memory"); __builtin_amdgcn_s_barrier();
    }
};
struct EpiMerge {
    static constexpr bool PERM = true;
    bf16_t* gs; bf16_t* ma; bf16_t* MG; const float* SS; LAS unsigned char* lds;
    __device__ __forceinline__ void preload(const GUnit&, int, f32x4&, f32x4&) const {}
    __device__ __forceinline__ void finish(const GUnit& u, int tid, int ui, const f32x4&, const f32x4&) const {
        if (u.aux == 0) { f32x4 a = (f32x4){0.f, 0.f, 0.f, 0.f}, b = a; rs_preload(SS, u, tid, a, b); rs_finish(lds, tid, ui >> 3, a, b); } }
    __device__ __forceinline__ void operator()(EPI_ARGS) const {
        const int sub = u.aux, b = sub >> 1;
        const int row0 = u.pm + wr * 64 + fr, col0 = u.pn + wc * 32 + 8 * fq;
        if ((sub & 1) == 0) {
            float rs[2][4]; rs_get(lds, ui >> 3, wr, fr, rs);
#pragma unroll
            for (int ai = 0; ai < 2; ++ai)
#pragma unroll
                for (int m = 0; m < 4; ++m) rs[ai][m] *= (1.f / GATE_WSCALE);
#pragma unroll
            for (int ai = 0; ai < 2; ++ai)
#pragma unroll
                for (int m = 0; m < 4; ++m)
#pragma unroll
                    for (int bj = 0; bj < 2; ++bj) {
                        const int slot = ((ai * 4 + m) * 2 + bj);
                        const f32x4 v0 = acc[ai][bj][m][0] * rs[ai][m], v1 = acc[ai][bj][m][1] * rs[ai][m];
                        const u32x4 lg = (u32x4){cvtpk(v0[0], v0[1]), cvtpk(v0[2], v0[3]), cvtpk(v1[0], v1[1]), cvtpk(v1[2], v1[3])};
                        if (slot < 6) keep[slot] = lg;
                        else *(u32x4*)(gs + ((size_t)slot * NTHREADS + tid) * 8) = lg;
                    }
        } else {
#pragma unroll
            for (int bt = 0; bt < 2; ++bt) {
                u32x4 g[8], pm[8];
#pragma unroll
                for (int j = 0; j < 8; ++j) { const int slot = bt * 8 + j; {
                        g[j] = (slot < 6) ? keep[slot & 7] : *(const u32x4*)(gs + ((size_t)slot * NTHREADS + tid) * 8);
                        pm[j] = (b > 0) ? *(const u32x4*)(ma + ((size_t)slot * NTHREADS + tid) * 8) : (u32x4){0u, 0u, 0u, 0u}; } }
#pragma unroll
                for (int j = 0; j < 8; ++j) { const int slot = bt * 8 + j; { const int ai = slot >> 3, m = (slot >> 1) & 3, bj = slot & 1;
                        const f32x4 v0 = acc[ai][bj][m][0], v1 = acc[ai][bj][m][1]; const u32x4 gg = g[j], pp = pm[j];
                        const f32x4 r0 = (f32x4){sigmoidf_(bflo(gg[0])) * v0[0] + bflo(pp[0]), sigmoidf_(bfhi(gg[0])) * v0[1] + bfhi(pp[0]), sigmoidf_(bflo(gg[1])) * v0[2] + bflo(pp[1]), sigmoidf_(bfhi(gg[1])) * v0[3] + bfhi(pp[1])};
                        const f32x4 r1 = (f32x4){sigmoidf_(bflo(gg[2])) * v1[0] + bflo(pp[2]), sigmoidf_(bfhi(gg[2])) * v1[1] + bfhi(pp[2]), sigmoidf_(bflo(gg[3])) * v1[2] + bflo(pp[3]), sigmoidf_(bfhi(gg[3])) * v1[3] + bfhi(pp[3])};
                        const u32x4 outw = (u32x4){cvtpk(r0[0], r0[1]), cvtpk(r0[2], r0[3]), cvtpk(r1[0], r1[1]), cvtpk(r1[2], r1[3])};
                        if (b < 3) *(u32x4*)(ma + ((size_t)slot * NTHREADS + tid) * 8) = outw;
                        else *(u32x4*)(MG + (size_t)(row0 + ai * HALF + m * 16) * DM + col0 + bj * HALF) = outw; } }
                asm volatile("" ::: "memory"); __builtin_amdgcn_sched_barrier(0);
            }
        }
    }
};
#undef EPI_ARGS
}
template <int MAP> __device__ __forceinline__ int cmap(int n) {
    if (MAP == 0) return n;
    if (MAP == 1) return n < C_GZ ? n : (n < C_NG ? n + 12 : (n < C_NG + 12 ? n - 1024 : -1));
    if (MAP == 2) return 5900 + n;
    return ((n & 255) < 128) ? ((n >> 8) * 128 + (n & 127)) : (DFF + (n >> 8) * 128 + (n & 127));
}
template <int MAP, bool F8 = false>
__device__ __forceinline__ void convert_T(const Frame& F, const float* src, int src_ld, int K, bf16_t* dst, int dst_ld, int NN, const float* kscale) {
    LAS float* tile = (LAS float*)F.lds;
    const int tk = K / 64, tn = NN / 128, total = tk * tn;
    const int lk = F.tid >> 5, ln = (F.tid & 31) * 4;
    f32x4 cur[4], nxt[4];
#define CVT_LOAD(dstv, t_) do { const int n0_ = ((t_) / tk) * 128, k0_ = ((t_) % tk) * 64; const int col_ = cmap<MAP>(n0_ + ln); \
        _Pragma("unroll") for (int i = 0; i < 4; ++i) { const int kk_ = k0_ + lk + 16 * i; \
            dstv[i] = (col_ >= 0) ? *(const f32x4*)(src + (size_t)kk_ * src_ld + col_) * (kscale ? kscale[kk_] : 1.f) : (f32x4){0.f, 0.f, 0.f, 0.f}; } } while (0)
    int t = F.wg;
    if (t < total) CVT_LOAD(cur, t);
    for (; t < total; t += F.G) {
        const int tn_ = t + F.G;
        if (tn_ < total) CVT_LOAD(nxt, tn_);
#pragma unroll
        for (int i = 0; i < 4; ++i) { LAS float* tp = tile + (lk + 16 * i) * 129 + ln; tp[0] = cur[i][0]; tp[1] = cur[i][1]; tp[2] = cur[i][2]; tp[3] = cur[i][3]; }
        __syncthreads();
        { const int n0 = (t / tk) * 128, k0 = (t % tk) * 64; const int r = F.tid >> 2, cseg = (F.tid & 3) * 16; float v[16];
#pragma unroll
          for (int j = 0; j < 16; ++j) v[j] = tile[(cseg + j) * 129 + r];
          bf16_t* dp = dst + (size_t)(n0 + r) * dst_ld + k0 + cseg;
          if (F8) {
              *(u32x4*)((unsigned char*)dst + (size_t)(n0 + r) * dst_ld * 2 + k0 + cseg) = (u32x4){cvt4_fp8(v[0] * GATE_WSCALE, v[1] * GATE_WSCALE, v[2] * GATE_WSCALE, v[3] * GATE_WSCALE),
                  cvt4_fp8(v[4] * GATE_WSCALE, v[5] * GATE_WSCALE, v[6] * GATE_WSCALE, v[7] * GATE_WSCALE), cvt4_fp8(v[8] * GATE_WSCALE, v[9] * GATE_WSCALE, v[10] * GATE_WSCALE, v[11] * GATE_WSCALE),
                  cvt4_fp8(v[12] * GATE_WSCALE, v[13] * GATE_WSCALE, v[14] * GATE_WSCALE, v[15] * GATE_WSCALE)};
          } else {
          *(u32x4*)dp = (u32x4){cvtpk(v[0], v[1]), cvtpk(v[2], v[3]), cvtpk(v[4], v[5]), cvtpk(v[6], v[7])};
          *(u32x4*)(dp + 8) = (u32x4){cvtpk(v[8], v[9]), cvtpk(v[10], v[11]), cvtpk(v[12], v[13]), cvtpk(v[14], v[15])}; } }
        __syncthreads();
#pragma unroll
        for (int i = 0; i < 4; ++i) cur[i] = nxt[i];
    }
#undef CVT_LOAD
}
__device__ __forceinline__ void convert_plain(const Frame& F, const float* src, bf16_t* dst, size_t n) {
    for (size_t i = ((size_t)F.wg * NTHREADS + F.tid) * 8; i < n; i += (size_t)F.G * NTHREADS * 8) {
        const f32x4 a = *(const f32x4*)(src + i), b = *(const f32x4*)(src + i + 4);
        *(u32x4*)(dst + i) = (u32x4){cvtpk(a[0], a[1]), cvtpk(a[2], a[3]), cvtpk(b[0], b[1]), cvtpk(b[2], b[3])};
    }
}
template <bool OUTF32>
__device__ __forceinline__ void rmsnorm_rows(const Frame& F, const float* x, const float* w, bf16_t* dstb, float* dstf, int rows) {
    for (int r = F.wg * 8 + F.wave; r < rows; r += F.G * 8) {
        const float* xp = x + (size_t)r * DM; f32x4 v[8]; float ss = 0.f;
#pragma unroll
        for (int i = 0; i < 8; ++i) { v[i] = *(const f32x4*)(xp + i * 256 + F.lane * 4); ss += v[i][0] * v[i][0] + v[i][1] * v[i][1] + v[i][2] * v[i][2] + v[i][3] * v[i][3]; }
        ss = wave_sum(ss);
        const float rs = rsqrtf(ss * (1.f / DM) + 1e-6f);
#pragma unroll
        for (int i = 0; i < 8; ++i) { const f32x4 g = *(const f32x4*)(w + i * 256 + F.lane * 4); const f32x4 y = v[i] * rs * g;
            if (OUTF32) *(f32x4*)(dstf + (size_t)r * DM + i * 256 + F.lane * 4) = y;
            else *(u32x2*)(dstb + (size_t)r * DM + i * 256 + F.lane * 4) = (u32x2){cvtpk(y[0], y[1]), cvtpk(y[2], y[3])}; }
    }
}

__device__ __forceinline__ void final_norm(const Frame& F, float* out, const float* w, const float* SS) {
    const bf16_t* XH = (const bf16_t*)(F.ws + WS_H);
    for (int r = F.wg * 8 + F.wave; r < MT; r += F.G * 8) {
        const float* sp = SS + (size_t)r * 8; const f32x4 a = *(const f32x4*)sp, b = *(const f32x4*)(sp + 4);
        const float rs = rsqrtf((((a[0] + a[1]) + (a[2] + a[3])) + ((b[0] + b[1]) + (b[2] + b[3]))) * (1.f / 2048.f) + 1e-6f);
#pragma unroll
        for (int i = 0; i < 4; ++i) { const size_t o = (size_t)r * DM + i * 512 + F.lane * 8;
            const u32x4 h = *(const u32x4*)(XH + o); const f32x4 w0 = *(const f32x4*)(w + i * 512 + F.lane * 8), w1 = *(const f32x4*)(w + i * 512 + F.lane * 8 + 4);
            *(f32x4*)(out + o) = (f32x4){bflo(h[0]) * rs * w0[0], bfhi(h[0]) * rs * w0[1], bflo(h[1]) * rs * w0[2], bfhi(h[1]) * rs * w0[3]};
            *(f32x4*)(out + o + 4) = (f32x4){bflo(h[2]) * rs * w1[0], bfhi(h[2]) * rs * w1[1], bflo(h[3]) * rs * w1[2], bfhi(h[3]) * rs * w1[3]}; }
    }
}

__device__ __forceinline__ void p0_prologue(const Frame& F) {
    unsigned char* ws = F.ws;
    for (int l = 0; l < DEPTH; ++l) {
        convert_T<1>(F, F.inp(4) + (size_t)l * DM * NIN, NIN, DM, (bf16_t*)(ws + WS_WIN) + (size_t)l * NP * DM, DM, NP, F.inp(3) + l * DM);
        convert_T<2, true>(F, F.inp(4) + (size_t)l * DM * NIN, NIN, DM, (bf16_t*)(ws + WS_WG) + (size_t)l * 8192 * DM, DM, 8192, F.inp(3) + l * DM);
        for (int b = 0; b < 4; ++b)
            convert_T<0>(F, F.inp(22) + ((size_t)l * 4 + b) * 512 * DM, DM, 512, (bf16_t*)(ws + WS_WB) + (size_t)l * DM * DM + b * 512, DM, DM, nullptr);
        convert_T<0>(F, F.inp(23) + (size_t)l * DM * DM, DM, DM, (bf16_t*)(ws + WS_WO) + (size_t)l * DM * DM, DM, DM, nullptr);
        convert_T<3>(F, F.inp(29) + (size_t)l * DM * 2 * DFF, 2 * DFF, DM, (bf16_t*)(ws + WS_FF1) + (size_t)l * 2 * DFF * DM, DM, 2 * DFF, F.inp(28) + l * DM);
        convert_T<0>(F, F.inp(30) + (size_t)l * DFF * DM, DM, DFF, (bf16_t*)(ws + WS_FF2) + (size_t)l * DM * DFF, DFF, DM, nullptr);
        convert_T<0>(F, F.inp(13) + (size_t)l * 4096 * 256, 256, 4096, (bf16_t*)(ws + WS_CW1) + ((size_t)l * 2 + 0) * 256 * 4096, 4096, 256, nullptr);
        convert_T<0>(F, F.inp(16) + (size_t)l * 4096 * 256, 256, 4096, (bf16_t*)(ws + WS_CW1) + ((size_t)l * 2 + 1) * 256 * 4096, 4096, 256, nullptr);
        convert_T<0>(F, F.inp(14) + (size_t)l * 256 * 128, 128, 256, (bf16_t*)(ws + WS_CW2) + ((size_t)l * 2 + 0) * 128 * 256, 256, 128, nullptr);
        convert_T<0>(F, F.inp(17) + (size_t)l * 256 * 128, 128, 256, (bf16_t*)(ws + WS_CW2) + ((size_t)l * 2 + 1) * 128 * 256, 256, 128, nullptr);
        convert_T<0>(F, F.inp(26) + (size_t)l * DM * 2 * DM, 2 * DM, DM, (bf16_t*)(ws + WS_WKVT) + (size_t)l * 2 * DM * DM, DM, 2 * DM, nullptr);
        convert_T<0>(F, F.inp(27) + (size_t)l * DM * DM, DM, DM, (bf16_t*)(ws + WS_WOT) + (size_t)l * DM * DM, DM, DM, nullptr);
    }
    for (size_t i = ((size_t)F.wg * NTHREADS + F.tid) * 8; i < (size_t)DEPTH * DM * DM; i += (size_t)F.G * NTHREADS * 8) {
        const float g = F.inp(24)[i >> 11];
        const f32x4 a = *(const f32x4*)(F.inp(25) + i) * g, b = *(const f32x4*)(F.inp(25) + i + 4) * g;
        *(u32x4*)((bf16_t*)(ws + WS_WQB) + i) = (u32x4){cvtpk(a[0], a[1]), cvtpk(a[2], a[3]), cvtpk(b[0], b[1]), cvtpk(b[2], b[3])};
    }
    for (int r = F.wg * 8 + F.wave; r < MT; r += F.G * 8) {
        const float* xp = F.inp(0) + (size_t)r * DM; float ss = 0.f;
#pragma unroll
        for (int i = 0; i < 8; ++i) { const f32x4 v = *(const f32x4*)(xp + i * 256 + F.lane * 4);
            const unsigned h0 = cvtpk(v[0], v[1]), h1 = cvtpk(v[2], v[3]);
            ss += bflo(h0) * bflo(h0) + bfhi(h0) * bfhi(h0) + bflo(h1) * bflo(h1) + bfhi(h1) * bfhi(h1);
            *(u32x2*)((bf16_t*)(ws + WS_H) + (size_t)r * DM + i * 256 + F.lane * 4) = (u32x2){h0, h1};
            *(unsigned*)(ws + WS_WG + 2048 + (size_t)r * 4096 + i * 256 + F.lane * 4) = cvt4_fp8(v[0], v[1], v[2], v[3]);
            }
        ss = wave_sum(ss);
        if (F.lane < 8) ((float*)(ws + WS_SS))[(size_t)r * 8 + F.lane] = F.lane == 0 ? ss : 0.f;
    }
    rmsnorm_rows<false>(F, F.inp(1), F.inp(2), (bf16_t*)(ws + WS_MEMN), nullptr, NBATCH * NMEM);
    const int gt = F.wg * NTHREADS + F.tid, gn = F.G * NTHREADS;
    for (int i = gt; i < DEPTH * 4 * 128 * 128; i += gn) { const int s = i & 127, t = (i >> 7) & 127; ((bf16_t*)(ws + WS_GMW))[i] = f2bf(s <= t ? F.inp(20)[i] : 0.f); }
    float* tab = (float*)(ws + WS_TAB);
    for (int i = gt; i < 512; i += gn) {
        float v[DEPTH], mx = -1e30f, sum = 0.f;
#pragma unroll
        for (int l = 0; l < DEPTH; ++l) { v[l] = F.inp(5)[l * 512 + i]; mx = fmaxf(mx, v[l]); }
#pragma unroll
        for (int l = 0; l < DEPTH; ++l) { v[l] = __expf(v[l] - mx); sum += v[l]; }
        float cum = 0.f;
#pragma unroll
        for (int l = 0; l < DEPTH; ++l) { if (l > 0) cum += v[l] / sum; tab[TAB_LB / 4 + l * 512 + i] = cum; }
    }
    if (gt < DEPTH) { const int l = gt; float s1 = 0.f, s2 = 0.f;
        for (int i = 0; i < 64; ++i) { s1 += F.inp(7)[l * 64 + i] * F.inp(8)[l * 64 + i]; s2 += F.inp(9)[l * 64 + i] * F.inp(10)[l * 64 + i]; }
        const float linit = 0.8f - 0.6f * expf(-0.3f * (float)l);
        tab[TAB_LAM / 4 + l] = expf(s1) - expf(s2) + linit; }
    for (int i = F.wg * 8 + F.wave; i < DEPTH * 2 * 256; i += F.G * 8) { const int l = i >> 9, kv = (i >> 8) & 1, n = i & 255;
        const float* pos = F.inp(kv ? 15 : 12) + (size_t)l * 4096; const float* w1 = F.inp(kv ? 16 : 13) + (size_t)l * 4096 * 256 + n;
        float s = 0.f; for (int k = F.lane; k < 4096; k += 64) s += pos[k] * w1[(size_t)k * 256];
        s = wave_sum(s); if (F.lane == 0) tab[TAB_CBIAS / 4 + i] = s; }
}

__device__ __forceinline__ void compress2(const Frame& F, int l) {
    const bf16_t* HC = (const bf16_t*)(F.ws + WS_HC); const bf16_t* W2 = (const bf16_t*)(F.ws + WS_CW2) + (size_t)l * 2 * 128 * 256;
    const int r = F.lane & 15, q = F.lane >> 4;
    for (int tile = F.wg * 8 + F.wave; tile < 256; tile += F.G * 8) {
        const int kv = tile >> 7, r0 = (tile & 127) * 16;
        const bf16_t* ap = HC + ((size_t)kv * 2048 + r0 + r) * 256 + q * 8; const bf16_t* bp = W2 + (size_t)kv * 128 * 256 + (size_t)r * 256 + q * 8;
        bf16x8 a[8];
#pragma unroll
        for (int ks = 0; ks < 8; ++ks) a[ks] = *(const bf16x8*)(ap + ks * 32);
        bf16_t* op = (bf16_t*)(F.ws + (kv ? WS_VC : WS_KC)) + (size_t)r0 * 128;
#pragma unroll
        for (int nt = 0; nt < 8; ++nt) { f32x4 acc = (f32x4){0.f, 0.f, 0.f, 0.f};
#pragma unroll
            for (int ks = 0; ks < 8; ++ks) acc = __builtin_amdgcn_mfma_f32_16x16x32_bf16(a[ks], *(const bf16x8*)(bp + (size_t)nt * 16 * 256 + ks * 32), acc, 0, 0, 0);
#pragma unroll
            for (int i = 0; i < 4; ++i) op[(size_t)(4 * q + i) * 128 + nt * 16 + r] = f2bf(acc[i] * 1.0f); }
    }
}

__device__ __forceinline__ void xa_softmax(const Frame& F) {
    const float* S = (const float*)(F.ws + WS_S); bf16_t* Pq = (bf16_t*)(F.ws + WS_PXA);
    for (int r = F.wg * 8 + F.wave; r < MT; r += F.G * 8) {
        const float* sp = S + (size_t)r * 1024 + F.lane * 16; f32x4 v[4]; float mx = -1e30f;
#pragma unroll
        for (int i = 0; i < 4; ++i) { v[i] = *(const f32x4*)(sp + 4 * i); mx = fmaxf(mx, fmaxf(fmaxf(v[i][0], v[i][1]), fmaxf(v[i][2], v[i][3]))); }
#pragma unroll
        for (int o = 8; o >= 1; o >>= 1) mx = fmaxf(mx, __shfl_xor(mx, o));
        float sum = 0.f;
#pragma unroll
        for (int i = 0; i < 4; ++i)
#pragma unroll
            for (int e = 0; e < 4; ++e) { v[i][e] = __expf(v[i][e] - mx); sum += v[i][e]; }
#pragma unroll
        for (int o = 8; o >= 1; o >>= 1) sum += __shfl_xor(sum, o);
        const float inv = 1.f / sum;
        u32x4 o0 = (u32x4){cvtpk(v[0][0] * inv, v[0][1] * inv), cvtpk(v[0][2] * inv, v[0][3] * inv), cvtpk(v[1][0] * inv, v[1][1] * inv), cvtpk(v[1][2] * inv, v[1][3] * inv)};
        u32x4 o1 = (u32x4){cvtpk(v[2][0] * inv, v[2][1] * inv), cvtpk(v[2][2] * inv, v[2][3] * inv), cvtpk(v[3][0] * inv, v[3][1] * inv), cvtpk(v[3][2] * inv, v[3][3] * inv)};
        bf16_t* op = Pq + (size_t)r * 1024 + F.lane * 16; *(u32x4*)op = o0; *(u32x4*)(op + 8) = o1;
    }
}

__device__ __forceinline__ int q_next(const Frame& F, unsigned* ctr) {
    LAS int* slot = (LAS int*)(F.lds + LDS_BARW + 16);
    __syncthreads();
    if (F.tid == 0) *slot = (int)__hip_atomic_fetch_add(ctr, 1u, __ATOMIC_RELAXED, __HIP_MEMORY_SCOPE_AGENT);
    __syncthreads();
    return __builtin_amdgcn_readfirstlane(*slot);
}
__device__ __forceinline__ int q_issue(const Frame& F, unsigned* ctr) { { unsigned long long a_ = (unsigned long long)ctr; asm volatile("" : "+s"(a_)); ctr = (unsigned*)a_; }
    int v = 0; if (F.tid == 0) v = (int)__hip_atomic_fetch_add(ctr, 1u, __ATOMIC_RELAXED, __HIP_MEMORY_SCOPE_AGENT); return v; }
__device__ __forceinline__ void q_post(const Frame& F, int v) { if (F.tid == 0) *(LAS int*)(F.lds + LDS_BARW + 16) = v; }
__device__ __forceinline__ int q_read(const Frame& F) { __syncthreads(); return __builtin_amdgcn_readfirstlane(*(LAS int*)(F.lds + LDS_BARW + 16)); }
namespace at {
constexpr int SHM_K = 16384, SHM_V = 16384, OFF_V = 0, OFF_K = 32768, OFF_WS = 65536, OFF_END = 65536 + 2048;
constexpr float LOG2E = 1.4426950408889634f;
constexpr unsigned WINF = 0x40000000u;
#define KSWZ(row, colB) ((row) * 256 + ((colB) ^ (((row) & 7) << 4)))
#define SBAR() __builtin_amdgcn_sched_barrier(0)
__device__ __forceinline__ int v_st(int k, int c) { const int kk = (k & ~0xC) | ((k & 4) << 1) | ((k & 8) >> 1); return ((kk >> 3) * 4 + (c >> 5)) * 512 + ((kk & 7) * 32 + (c & 31)) * 2; }
__device__ __forceinline__ int v_rd_base(int lane) { return ((lane & 3) << 3) | (((lane >> 2) & 3) << 6) | (((lane >> 4) & 1) << 5) | (((lane >> 5) & 1) << 8); }
constexpr int v_rd_off(int d0, int ks, int half) { return d0 * 512 + ks * 4096 + half * 2048; }
__device__ __forceinline__ int crow(int r, int hi) { return (r & 3) + 8 * (r >> 2) + 4 * hi; }

__device__ __forceinline__ void mask_tile(f32x16& p0, f32x16& p1, int dq, unsigned W) {
    const float NEG = -__builtin_inff();
#pragma unroll
    for (int r = 0; r < 16; ++r) {
        const int c = (r & 3) + 8 * (r >> 2);
        if ((unsigned)(dq - c) >= W) p0[r] = NEG;
        if ((unsigned)(dq - c - 32) >= W) p1[r] = NEG;
    }
}
template <int NEXP = 16>
__device__ __forceinline__ void partialSM(f32x16& p0, f32x16& p1, float& m_reg, float& mn, float& alpha, float C2) {
    float pmax = p0[0];
#pragma unroll
    for (int r = 1; r < 16; ++r) pmax = fmaxf(pmax, p0[r]);
#pragma unroll
    for (int r = 0; r < 16; ++r) pmax = fmaxf(pmax, p1[r]);
    { auto rr = __builtin_amdgcn_permlane32_swap(__float_as_uint(pmax), __float_as_uint(pmax), false, false);
      pmax = fmaxf(__uint_as_float(rr[0]), __uint_as_float(rr[1])); }
    if (__builtin_expect(__all((pmax - m_reg) * C2 <= 11.5f), 1)) { mn = m_reg; alpha = 1.f; }
    else { mn = fmaxf(m_reg, pmax); alpha = __builtin_amdgcn_exp2f((m_reg - mn) * C2); m_reg = mn; }
    const float mnL = -mn * C2;
#pragma unroll
    for (int r = 0; r < 16; ++r) p0[r] = fmaf(p0[r], C2, mnL);
#pragma unroll
    for (int r = 0; r < 16; ++r) p1[r] = fmaf(p1[r], C2, mnL);
#pragma unroll
    for (int r = 0; r < NEXP; ++r) p0[r] = __builtin_amdgcn_exp2f(p0[r]);
}
#define PK4(P, B_, OUT) do { unsigned a0 = cvtpk(P[B_+0], P[B_+1]), a1 = cvtpk(P[B_+2], P[B_+3]);                          \
        unsigned b0 = cvtpk(P[B_+4], P[B_+5]), b1 = cvtpk(P[B_+6], P[B_+7]);                                             \
        auto r0 = __builtin_amdgcn_permlane32_swap(a0, b0, false, false); auto r1 = __builtin_amdgcn_permlane32_swap(a1, b1, false, false); \
        u32x4 w = {r0[0], r1[0], r0[1], r1[1]}; OUT = *reinterpret_cast<bf16x8*>(&w); } while (0)
__device__ __forceinline__ void pack_p(const f32x16& p0, const f32x16& p1, bf16x8& pa0, bf16x8& pa1, bf16x8& pa2, bf16x8& pa3) {
    PK4(p0, 0, pa0); PK4(p0, 8, pa1); PK4(p1, 0, pa2); PK4(p1, 8, pa3);
}
__device__ __forceinline__ void finishSM(f32x16& p0, f32x16& p1, float alpha, float& l_reg, bf16x8& pa0, bf16x8& pa1, bf16x8& pa2, bf16x8& pa3) {
#pragma unroll
    for (int r = 0; r < 16; ++r) p1[r] = __builtin_amdgcn_exp2f(p1[r]);
    float ps = 0;
#pragma unroll
    for (int r = 0; r < 16; ++r) ps += p0[r];
#pragma unroll
    for (int r = 0; r < 16; ++r) ps += p1[r];
    { auto rr = __builtin_amdgcn_permlane32_swap(__float_as_uint(ps), __float_as_uint(ps), false, false);
      ps = __uint_as_float(rr[0]) + __uint_as_float(rr[1]); }
    l_reg = l_reg * alpha + ps;
    pack_p(p0, p1, pa0, pa1, pa2, pa3);
}
template <int DN>
__device__ __forceinline__ void qkt(f32x16& p0, f32x16& p1, const LAS unsigned char* Kb, int r32, int hi, const bf16x8 (&qr)[DN], int kcoloff) {
    p0 = f32x16{}; p1 = f32x16{};
    const LAS unsigned char* kb[4];
#pragma unroll
    for (int dd = 0; dd < 4; ++dd) kb[dd] = Kb + kcoloff + KSWZ(r32, (dd * 16 + hi * 8) * 2);
#pragma unroll
    for (int d0 = 0; d0 < DN; ++d0) { const LAS unsigned char* a = kb[d0 & 3] + (d0 >> 2) * 128;
        const bf16x8 b0 = *reinterpret_cast<const LAS bf16x8*>(a);
        const bf16x8 b1 = *reinterpret_cast<const LAS bf16x8*>(a + 32 * 256);
        p0 = __builtin_amdgcn_mfma_f32_32x32x16_bf16(b0, qr[d0], p0, 0, 0, 0);
        p1 = __builtin_amdgcn_mfma_f32_32x32x16_bf16(b1, qr[d0], p1, 0, 0, 0); }
}
template <int VB>
__device__ __forceinline__ void pv_tile(f32x16 (&o)[4], int vb0, bf16x8 pa0, bf16x8 pa1, bf16x8 pa2, bf16x8 pa3) {
#define TRRD(dst, off) asm volatile("ds_read_b64_tr_b16 %0, %1 offset:%2" : "=&v"(dst) : "v"(vb0), "i"(off) : "memory")
#define PV_D0(d0) do { s16x4 l0, l1, l2, l3, h0, h1, h2, h3; constexpr int b_ = VB * SHM_V + v_rd_off(d0, 0, 0); \
        TRRD(l0, b_); TRRD(h0, b_ + 2048); TRRD(l1, b_ + 4096); TRRD(h1, b_ + 6144); TRRD(l2, b_ + 8192); TRRD(h2, b_ + 10240); TRRD(l3, b_ + 12288); TRRD(h3, b_ + 14336); \
        asm volatile("s_waitcnt lgkmcnt(0)" ::: "memory"); SBAR();   \
        o[d0] = __builtin_amdgcn_mfma_f32_32x32x16_bf16(pa0, (bf16x8){l0[0], l0[1], l0[2], l0[3], h0[0], h0[1], h0[2], h0[3]}, o[d0], 0, 0, 0);   \
        o[d0] = __builtin_amdgcn_mfma_f32_32x32x16_bf16(pa1, (bf16x8){l1[0], l1[1], l1[2], l1[3], h1[0], h1[1], h1[2], h1[3]}, o[d0], 0, 0, 0);   \
        o[d0] = __builtin_amdgcn_mfma_f32_32x32x16_bf16(pa2, (bf16x8){l2[0], l2[1], l2[2], l2[3], h2[0], h2[1], h2[2], h2[3]}, o[d0], 0, 0, 0);   \
        o[d0] = __builtin_amdgcn_mfma_f32_32x32x16_bf16(pa3, (bf16x8){l3[0], l3[1], l3[2], l3[3], h3[0], h3[1], h3[2], h3[3]}, o[d0], 0, 0, 0); } while (0)
    PV_D0(0); PV_D0(1); PV_D0(2); PV_D0(3);
#undef PV_D0
#undef TRRD
}
template <int VB>
__device__ __forceinline__ void finish_pv(f32x16& p0, f32x16& p1, float alpha, float& l_reg, f32x16 (&o)[4], int vb0,
                                          const bf16x8& sk0, const bf16x8& sk1, const bf16x8& sv0, const bf16x8& sv1, LAS unsigned char* wk, LAS unsigned char* wv0, LAS unsigned char* wv1) {
#define TRRD(dst, off) asm volatile("ds_read_b64_tr_b16 %0, %1 offset:%2" : "=&v"(dst) : "v"(vb0), "i"(off) : "memory")
#define FPV_RD(L_, H_, g) do { _Pragma("unroll") for (int d_ = 0; d_ < 4; ++d_) { } TRRD(L_[0], VB * SHM_V + v_rd_off(0, 0, 0) + (g) * 4096); TRRD(H_[0], VB * SHM_V + v_rd_off(0, 0, 0) + (g) * 4096 + 2048); \
        TRRD(L_[1], VB * SHM_V + v_rd_off(1, 0, 0) + (g) * 4096); TRRD(H_[1], VB * SHM_V + v_rd_off(1, 0, 0) + (g) * 4096 + 2048);              \
        TRRD(L_[2], VB * SHM_V + v_rd_off(2, 0, 0) + (g) * 4096); TRRD(H_[2], VB * SHM_V + v_rd_off(2, 0, 0) + (g) * 4096 + 2048);              \
        TRRD(L_[3], VB * SHM_V + v_rd_off(3, 0, 0) + (g) * 4096); TRRD(H_[3], VB * SHM_V + v_rd_off(3, 0, 0) + (g) * 4096 + 2048); } while (0)
#define FPV_MMA(PA, L_, H_, d0) o[d0] = __builtin_amdgcn_mfma_f32_32x32x16_bf16(PA, (bf16x8){L_[d0][0], L_[d0][1], L_[d0][2], L_[d0][3], H_[d0][0], H_[d0][1], H_[d0][2], H_[d0][3]}, o[d0], 0, 0, 0)
#define FPV_WAIT() do { asm volatile("s_waitcnt lgkmcnt(0)" ::: "memory"); SBAR(); } while (0)
    bf16x8 pa; float ps = 0.f;
    s16x4 la[4], ha[4], lb[4], hb[4];
    FPV_RD(la, ha, 0); PK4(p0, 0, pa); FPV_WAIT();
    FPV_RD(lb, hb, 1);
    FPV_MMA(pa, la, ha, 0); p0[8] = __builtin_amdgcn_exp2f(p0[8]); p0[9] = __builtin_amdgcn_exp2f(p0[9]); ps += p0[0]; ps += p0[1]; SBAR();
    FPV_MMA(pa, la, ha, 1); p0[10] = __builtin_amdgcn_exp2f(p0[10]); p0[11] = __builtin_amdgcn_exp2f(p0[11]); ps += p0[2]; ps += p0[3]; SBAR();
    FPV_MMA(pa, la, ha, 2); p0[12] = __builtin_amdgcn_exp2f(p0[12]); p0[13] = __builtin_amdgcn_exp2f(p0[13]); ps += p0[4]; ps += p0[5]; SBAR();
    FPV_MMA(pa, la, ha, 3); p0[14] = __builtin_amdgcn_exp2f(p0[14]); p0[15] = __builtin_amdgcn_exp2f(p0[15]); ps += p0[6]; ps += p0[7]; SBAR();
    PK4(p0, 8, pa); FPV_WAIT();
    FPV_RD(la, ha, 2);
    FPV_MMA(pa, lb, hb, 0); p1[0] = __builtin_amdgcn_exp2f(p1[0]); p1[1] = __builtin_amdgcn_exp2f(p1[1]); ps += p0[8]; ps += p0[9]; SBAR();
    FPV_MMA(pa, lb, hb, 1); p1[2] = __builtin_amdgcn_exp2f(p1[2]); p1[3] = __builtin_amdgcn_exp2f(p1[3]); ps += p0[10]; ps += p0[11]; SBAR();
    FPV_MMA(pa, lb, hb, 2); p1[4] = __builtin_amdgcn_exp2f(p1[4]); p1[5] = __builtin_amdgcn_exp2f(p1[5]); ps += p0[12]; ps += p0[13]; SBAR();
    FPV_MMA(pa, lb, hb, 3); p1[6] = __builtin_amdgcn_exp2f(p1[6]); p1[7] = __builtin_amdgcn_exp2f(p1[7]); ps += p0[14]; ps += p0[15]; SBAR();
    PK4(p1, 0, pa); FPV_WAIT();
    FPV_RD(lb, hb, 3);
    FPV_MMA(pa, la, ha, 0); p1[8] = __builtin_amdgcn_exp2f(p1[8]); p1[9] = __builtin_amdgcn_exp2f(p1[9]); ps += p1[0]; ps += p1[1]; *(LAS bf16x8*)wk = sk0; SBAR();
    FPV_MMA(pa, la, ha, 1); p1[10] = __builtin_amdgcn_exp2f(p1[10]); p1[11] = __builtin_amdgcn_exp2f(p1[11]); ps += p1[2]; ps += p1[3]; *(LAS bf16x8*)(wk + 32 * 256) = sk1; SBAR();
    FPV_MMA(pa, la, ha, 2); p1[12] = __builtin_amdgcn_exp2f(p1[12]); p1[13] = __builtin_amdgcn_exp2f(p1[13]); ps += p1[4]; ps += p1[5]; SBAR();
    FPV_MMA(pa, la, ha, 3); p1[14] = __builtin_amdgcn_exp2f(p1[14]); p1[15] = __builtin_amdgcn_exp2f(p1[15]); ps += p1[6]; ps += p1[7]; SBAR();
    PK4(p1, 8, pa); FPV_WAIT();
    FPV_MMA(pa, lb, hb, 0); ps += p1[8]; ps += p1[9]; *(LAS bf16x8*)wv0 = sv0; SBAR();
    FPV_MMA(pa, lb, hb, 1); ps += p1[10]; ps += p1[11]; *(LAS bf16x8*)wv1 = sv1; SBAR();
    FPV_MMA(pa, lb, hb, 2); ps += p1[12]; ps += p1[13]; SBAR();
    FPV_MMA(pa, lb, hb, 3); ps += p1[14]; ps += p1[15]; SBAR();
    { auto rr = __builtin_amdgcn_permlane32_swap(__float_as_uint(ps), __float_as_uint(ps), false, false);
      ps = __uint_as_float(rr[0]) + __uint_as_float(rr[1]); }
    l_reg = l_reg * alpha + ps;
#undef FPV_RD
#undef FPV_MMA
#undef FPV_WAIT
#undef TRRD
}
struct Stg { bf16x8 k0, k1, v0, v1; };
__device__ __forceinline__ void stg_load(Stg& s, const bf16_t* Kg, size_t ldk, const bf16_t* Vg, size_t ldv, int kb, int sr, int sc) {
    s.k0 = *(const bf16x8*)(Kg + (size_t)(kb + sr) * ldk + sc); s.k1 = *(const bf16x8*)(Kg + (size_t)(kb + 32 + sr) * ldk + sc);
    s.v0 = *(const bf16x8*)(Vg + (size_t)(kb + sr) * ldv + sc); s.v1 = *(const bf16x8*)(Vg + (size_t)(kb + 32 + sr) * ldv + sc);
}
__device__ __forceinline__ void stg_write(const Stg& s, LAS unsigned char* lds, int buf, int kws, int vst0, int vst1) {
    *(LAS bf16x8*)(lds + OFF_K + buf * SHM_K + kws) = s.k0; *(LAS bf16x8*)(lds + OFF_K + buf * SHM_K + kws + 32 * 256) = s.k1;
    *(LAS bf16x8*)(lds + OFF_V + buf * SHM_V + vst0) = s.v0; *(LAS bf16x8*)(lds + OFF_V + buf * SHM_V + vst1) = s.v1;
}
struct Lane { int tid, wid, lane, r32, hi, sr, sc, kws, vst0, vst1, vb0; LAS float* li_l; LAS float* al_l; };
__device__ __forceinline__ Lane make_lane(LAS unsigned char* lds, int tid) {
    Lane L; L.tid = tid; L.wid = __builtin_amdgcn_readfirstlane(L.tid >> 6); L.lane = L.tid & 63; L.r32 = L.lane & 31; L.hi = L.lane >> 5;
    L.sr = L.tid >> 4; L.sc = (L.tid & 15) * 8; L.kws = KSWZ(L.sr, L.sc * 2); L.vst0 = v_st(L.sr, L.sc); L.vst1 = v_st(32 + L.sr, L.sc);
    L.vb0 = (int)(unsigned)(uintptr_t)(lds + OFF_V) + v_rd_base(L.lane);
    L.li_l = (LAS float*)(lds + OFF_WS) + L.wid * 64; L.al_l = L.li_l + 32; return L;
}
#define AT_RESC(a) do { if (__any((a) < 1.f)) { if (L.hi == 0) L.al_l[L.r32] = (a); asm volatile("s_waitcnt lgkmcnt(0)" ::: "memory");              \
        _Pragma("unroll") for (int d_ = 0; d_ < 4; ++d_) _Pragma("unroll") for (int r = 0; r < 16; ++r) o[d_][r] *= L.al_l[crow(r, L.hi)]; } } while (0)

template <int DN, int MODE, bool DO_PV>
__device__ __forceinline__ void attn_run(LAS unsigned char* lds, const Lane& L, const bf16_t* Kg, size_t ldk, const bf16_t* Vg, size_t ldv, int kt_lo, int kt_hi,
                                         const bf16x8 (&qr)[DN], int kcoloff, int rpos, int rmin, int rmax, unsigned W, const LAS unsigned* selp, float C2,
                                         float& m_reg, float& l_reg, f32x16 (&o)[4]) {
    Stg st; f32x16 p0, p1; bf16x8 pa0, pa1, pa2, pa3; float mn, alpha; unsigned selcur = 0u;
    if (kt_lo >= kt_hi) return;
    stg_load(st, Kg, ldk, Vg, ldv, kt_lo * 64, L.sr, L.sc);
    stg_write(st, lds, 0, L.kws, L.vst0, L.vst1);
    __syncthreads();
#define AT_STEP(t, B) do { const int kb_ = (t) * 64; const bool hn_ = (t) + 1 < kt_hi;                                                       \
        if (hn_) stg_load(st, Kg, ldk, Vg, ldv, kb_ + 64, L.sr, L.sc);                                                                        \
        bool act_ = (rmax >= kb_) && (rmin - (kb_ + 63) < (int)W);                                                                            \
        bool nm_ = !((rmin >= kb_ + 63) && (rmax - kb_ < (int)W)); unsigned Wl_ = W; bool sb_ = true, kill_ = false;                          \
        if (MODE == 1) { if (((t) & 31) == 0) selcur = selp[(t) >> 5]; sb_ = (selcur >> ((t) & 31)) & 1u;                                     \
                         Wl_ = sb_ ? W : 0u; act_ = act_ && __any(sb_); kill_ = !nm_ && !__all(sb_); }                                       \
        if (act_) { qkt<DN>(p0, p1, lds + OFF_K + (B) * SHM_K, L.r32, L.hi, qr, kcoloff);                                                     \
            if (nm_) mask_tile(p0, p1, rpos - kb_ - 4 * L.hi, Wl_);                                                                           \
            else if (kill_) { const float ninf_ = -__builtin_inff();     \
                _Pragma("unroll") for (int r = 0; r < 16; ++r) { p0[r] = sb_ ? p0[r] : ninf_; p1[r] = sb_ ? p1[r] : ninf_; } }                 \
            partialSM<DO_PV ? 8 : 16>(p0, p1, m_reg, mn, alpha, C2);                                                                           \
            if (DO_PV) AT_RESC(alpha);                                                                                                        \
            if (DO_PV) finish_pv<B>(p0, p1, alpha, l_reg, o, L.vb0, st.k0, st.k1, st.v0, st.v1, lds + OFF_K + (1 - (B)) * SHM_K + L.kws,      \
                                    lds + OFF_V + (1 - (B)) * SHM_V + L.vst0, lds + OFF_V + (1 - (B)) * SHM_V + L.vst1);                      \
            else finishSM(p0, p1, alpha, l_reg, pa0, pa1, pa2, pa3); }                                                                        \
        if (hn_ && !(DO_PV && act_)) stg_write(st, lds, 1 - (B), L.kws, L.vst0, L.vst1);                                                      \
        __syncthreads(); } while (0)
    for (int t = kt_lo; t < kt_hi; t += 2) {
        AT_STEP(t, 0);
        if (t + 1 < kt_hi) AT_STEP(t + 1, 1);
        else {
        }
    }
#undef AT_STEP
}
__device__ __forceinline__ void row_inv_l(const Lane& L, float l_reg, float (&rli)[16]) {
    if (L.hi == 0) L.li_l[L.r32] = l_reg; asm volatile("s_waitcnt lgkmcnt(0)" ::: "memory");
#pragma unroll
    for (int r = 0; r < 16; ++r) { const float lv = L.li_l[crow(r, L.hi)]; rli[r] = lv > 0.f ? __builtin_amdgcn_rcpf(lv) : 0.f; }
}

__device__ __forceinline__ void diff_attn_item(const Frame& F, int layer, int bh, int qt, unsigned* qctr) {
    LAS unsigned char* lds = F.lds; const Lane L = make_lane(lds, F.tid);
    const bf16_t* P = (const bf16_t*)(F.ws + WS_P); bf16_t* OALL = (bf16_t*)(F.ws + WS_OALL);
    const float lam = ((const float*)(F.ws + WS_TAB))[TAB_LAM / 4 + layer];
    const float linit = 0.8f - 0.6f * expf(-0.3f * (float)layer);
    const float* nw = F.inp(11) + layer * 128;
    const int map = L.wid >> 2, wq = L.wid & 3;
    LAS float* OB = (LAS float*)lds;
    const int b = bh >> 2, h = bh & 3;
    const int tok0 = qt * 128 + wq * 32, pos = tok0 + L.r32;
    const bf16_t* Pb = P + (size_t)b * SEQ * NP;
    bf16x8 qr[4];
#pragma unroll
    for (int i = 0; i < 4; ++i) qr[i] = *(const bf16x8*)(Pb + (size_t)pos * NP + C_DQ + h * 128 + map * 64 + i * 16 + L.hi * 8);
    float m_reg = -1e30f, l_reg = 0.f; f32x16 o[4] = {};
    attn_run<4, 0, true>(lds, L, Pb + C_DK + h * 128, NP, Pb + C_DV + h * 128, NP, 0, 2 * qt + 2, qr, map * 128, pos, tok0, tok0 + 31, WINF, (const LAS unsigned*)nullptr,
                         LOG2E * 0.125f, m_reg, l_reg, o);
    const int qn = q_issue(F, qctr);
    float rli[16]; row_inv_l(L, l_reg, rli);
    __syncthreads();
#pragma unroll
    for (int r = 0; r < 16; ++r) { const int row = wq * 32 + crow(r, L.hi);
#pragma unroll
        for (int d0 = 0; d0 < 4; ++d0) OB[(map * 128 + row) * 132 + d0 * 32 + L.r32] = o[d0][r] * rli[r]; }
    __syncthreads();
    { const int t = F.tid >> 2, q4 = F.tid & 3; float v[32]; float ss = 0.f;
#pragma unroll
      for (int j = 0; j < 32; ++j) { v[j] = OB[t * 132 + q4 * 32 + j] - lam * OB[(128 + t) * 132 + q4 * 32 + j]; ss += v[j] * v[j]; }
      ss += __shfl_xor(ss, 1); ss += __shfl_xor(ss, 2);
      const float rs = rsqrtf(ss * (1.f / 128.f) + 1e-6f) * (1.f - linit);
      bf16_t* op = OALL + ((size_t)b * SEQ + qt * 128 + t) * DM + 512 + h * 128 + q4 * 32;
#pragma unroll
      for (int j = 0; j < 32; j += 8)
          *(u32x4*)(op + j) = (u32x4){cvtpk(v[j] * rs * nw[q4 * 32 + j], v[j + 1] * rs * nw[q4 * 32 + j + 1]), cvtpk(v[j + 2] * rs * nw[q4 * 32 + j + 2], v[j + 3] * rs * nw[q4 * 32 + j + 3]),
                                      cvtpk(v[j + 4] * rs * nw[q4 * 32 + j + 4], v[j + 5] * rs * nw[q4 * 32 + j + 5]), cvtpk(v[j + 6] * rs * nw[q4 * 32 + j + 6], v[j + 7] * rs * nw[q4 * 32 + j + 7])}; }
    __syncthreads();
    q_post(F, qn);
}

constexpr int NS_PT = OFF_END, NS_IMP = NS_PT + 8 * 2304, NS_SEL = NS_IMP + 64 * 256 * 4, NS_END = NS_SEL + 64 * 8 * 4;
__device__ __forceinline__ void nsa_item(const Frame& F, int b, int c) {
    LAS unsigned char* lds = F.lds; const Lane L = make_lane(lds, F.tid);
    const bf16_t* P = (const bf16_t*)(F.ws + WS_P); const bf16_t* KC = (const bf16_t*)(F.ws + WS_KC); const bf16_t* VC = (const bf16_t*)(F.ws + WS_VC);
    bf16_t* OALL = (bf16_t*)(F.ws + WS_OALL); float* NACC = (float*)(F.ws + WS_NACC);
    LAS float* PT = (LAS float*)(lds + NS_PT) + L.wid * 576;
    LAS float* IMP = (LAS float*)(lds + NS_IMP);
    LAS unsigned* SELL = (LAS unsigned*)(lds + NS_SEL);
    const float C2 = LOG2E * 0.08838834764831845f;
    const int tk = L.r32 >> 2, head = L.r32 & 3;
    const int tokw = c * 64 + L.wid * 8, pos = tokw + tk;
    const size_t grow = (size_t)b * SEQ + pos;
    const bf16_t* Pb = P + (size_t)b * SEQ * NP;
    bf16x8 qr[8];
#pragma unroll
    for (int i = 0; i < 8; ++i) qr[i] = *(const bf16x8*)(P + grow * NP + C_NQ + head * 128 + i * 16 + L.hi * 8);
    const int nt = ((4 * c + 3) + 63) >> 6;
    {
        const int rpos = (pos - 31) >> 4, rmin = (tokw - 31) >> 4, rmax = (tokw + 7 - 31) >> 4;
        const bf16_t* Kg = KC + (size_t)b * 1024 * 128; const bf16_t* Vg = VC + (size_t)b * 1024 * 128;
        float m_reg = -1e30f, l_reg = 0.f; f32x16 o[4] = {};
        attn_run<8, 0, false>(lds, L, Kg, 128, Vg, 128, 0, nt, qr, 0, rpos, rmin, rmax, WINF, (const LAS unsigned*)nullptr, C2, m_reg, l_reg, o);
        const float invl = l_reg > 0.f ? 1.f / l_reg : 0.f, mnL = -m_reg * C2;
        Stg st; f32x16 p0, p1; bf16x8 pa0, pa1, pa2, pa3;
        if (L.lane < 8) PT[512 + L.lane] = 0.f;
        stg_load(st, Kg, 128, Vg, 128, 0, L.sr, L.sc); stg_write(st, lds, 0, L.kws, L.vst0, L.vst1); __syncthreads();
#define CMP_STEP(t, B) do { const int kb_ = (t) * 64; const bool hn_ = (t) + 1 < nt;                                                         \
        if (hn_) stg_load(st, Kg, 128, Vg, 128, kb_ + 64, L.sr, L.sc);                                                                        \
        qkt<8>(p0, p1, lds + OFF_K + (B) * SHM_K, L.r32, L.hi, qr, 0);                                                                        \
        mask_tile(p0, p1, rpos - kb_ - 4 * L.hi, WINF);                                                                                       \
        _Pragma("unroll") for (int r = 0; r < 16; ++r) { p0[r] = __builtin_amdgcn_exp2f(fmaf(p0[r], C2, mnL)) * invl; p1[r] = __builtin_amdgcn_exp2f(fmaf(p1[r], C2, mnL)) * invl; } \
        _Pragma("unroll") for (int q = 0; q < 4; ++q) { f32x4 s0, s1;                                                                        \
            _Pragma("unroll") for (int e = 0; e < 4; ++e) { float a0 = p0[4 * q + e], a1 = p1[4 * q + e];                                    \
                a0 += __shfl_xor(a0, 1); a0 += __shfl_xor(a0, 2); a1 += __shfl_xor(a1, 1); a1 += __shfl_xor(a1, 2); s0[e] = a0; s1[e] = a1; } \
            if (head == 0) { *(LAS f32x4*)(PT + tk * 64 + 4 * L.hi + 8 * q) = s0; *(LAS f32x4*)(PT + tk * 64 + 4 * L.hi + 32 + 8 * q) = s1; } } \
        asm volatile("s_waitcnt lgkmcnt(0)" ::: "memory");                                                                                    \
        _Pragma("unroll") for (int x = 0; x < 2; ++x) { const int e_ = L.lane + 64 * x, tk_ = e_ >> 4, jb_ = e_ & 15; LAS float* pr_ = PT + tk_ * 64 + 4 * jb_; \
            const float pm1_ = jb_ == 0 ? PT[512 + tk_] : pr_[-1];                                                                            \
            IMP[(L.wid * 8 + tk_) * 256 + 16 * (t) + jb_] = pm1_ + 2.f * pr_[0] + 2.f * pr_[1] + 2.f * pr_[2] + pr_[3]; }                     \
        asm volatile("s_waitcnt lgkmcnt(0)" ::: "memory");                                                                                    \
        if (L.lane < 8) PT[512 + L.lane] = PT[L.lane * 64 + 63];                                                                              \
        pack_p(p0, p1, pa0, pa1, pa2, pa3); pv_tile<B>(o, L.vb0, pa0, pa1, pa2, pa3);                                                         \
        if (hn_) stg_write(st, lds, 1 - (B), L.kws, L.vst0, L.vst1);                                                                          \
        __syncthreads(); } while (0)
        for (int t = 0; t < nt; t += 2) { CMP_STEP(t, 0); if (t + 1 < nt) CMP_STEP(t + 1, 1); }
#undef CMP_STEP
#pragma unroll
        for (int r = 0; r < 16; ++r) { const int row = crow(r, L.hi), tk2 = row >> 2, hd = row & 3;
            const size_t gr = (size_t)b * SEQ + tokw + tk2;
            const float g = sigmoidf_(bf2f(P[gr * NP + C_NG + hd * 3 + 0]));
#pragma unroll
            for (int d0 = 0; d0 < 4; ++d0) NACC[gr * 512 + hd * 128 + d0 * 32 + L.r32] = g * o[d0][r]; }
    }
    for (int t8 = 0; t8 < 8; ++t8) {
        const int row = L.wid * 8 + t8, cur = c;
        f32x4 iv = (f32x4){0.f, 0.f, 0.f, 0.f};
        if (L.lane * 4 < 16 * nt) iv = *(const LAS f32x4*)(IMP + row * 256 + L.lane * 4);
        float sc[4];
#pragma unroll
        for (int i = 0; i < 4; ++i) { const int j = L.lane * 4 + i; const bool valid = j <= cur, forced = (j == 0) || (j > cur - 2);
            sc[i] = valid ? (forced ? 1e4f : iv[i]) : -1.f; }
        unsigned nib = 0u;
        for (int round = 0; round < 16; ++round) {
            const float best = fmaxf(fmaxf(sc[0], sc[1]), fmaxf(sc[2], sc[3]));
            const float wmax = wave_max(best);
            if (wmax < 0.f) break;
            const unsigned long long bal = __ballot(best == wmax);
            const int win = __ffsll((long long)bal) - 1;
            if (L.lane == win) {
                if (sc[0] == wmax) { sc[0] = -2.f; nib |= 1u; }
                else if (sc[1] == wmax) { sc[1] = -2.f; nib |= 2u; }
                else if (sc[2] == wmax) { sc[2] = -2.f; nib |= 4u; }
                else { sc[3] = -2.f; nib |= 8u; }
            }
        }
        unsigned word = nib << (4 * (L.lane & 7));
        word |= __shfl_xor(word, 1); word |= __shfl_xor(word, 2); word |= __shfl_xor(word, 4);
        if ((L.lane & 7) == 0) SELL[row * 8 + (L.lane >> 3)] = word;
    }
    asm volatile("s_waitcnt lgkmcnt(0)" ::: "memory");
    {
        float m_reg = -1e30f, l_reg = 0.f; f32x16 o[4] = {};
        attn_run<8, 1, true>(lds, L, Pb + C_KS, NP, Pb + C_VS, NP, 0, c + 1, qr, 0, pos, tokw, tokw + 7, WINF, (const LAS unsigned*)(SELL + (L.wid * 8 + tk) * 8), C2, m_reg, l_reg, o);
        float rli[16]; row_inv_l(L, l_reg, rli);
#pragma unroll
        for (int r = 0; r < 16; ++r) { const int row = crow(r, L.hi), tk2 = row >> 2, hd = row & 3;
            const size_t gr = (size_t)b * SEQ + tokw + tk2;
            const float g = sigmoidf_(bf2f(P[gr * NP + C_NG + hd * 3 + 1])) * rli[r];
#pragma unroll
            for (int d0 = 0; d0 < 4; ++d0) NACC[gr * 512 + hd * 128 + d0 * 32 + L.r32] += g * o[d0][r]; }
    }
    {
        float m_reg = -1e30f, l_reg = 0.f; f32x16 o[4] = {};
        attn_run<8, 0, true>(lds, L, Pb + C_KW, NP, Pb + C_VW, NP, c >= 8 ? c - 8 : 0, c + 1, qr, 0, pos, tokw, tokw + 7, 512u, (const LAS unsigned*)nullptr, C2, m_reg, l_reg, o);
        float rli[16]; row_inv_l(L, l_reg, rli);
#pragma unroll
        for (int r = 0; r < 16; ++r) { const int row = crow(r, L.hi), tk2 = row >> 2, hd = row & 3;
            const size_t gr = (size_t)b * SEQ + tokw + tk2;
            const float g = sigmoidf_(bf2f(P[gr * NP + C_NG + hd * 3 + 2])) * rli[r];
#pragma unroll
            for (int d0 = 0; d0 < 4; ++d0) { const float v = NACC[gr * 512 + hd * 128 + d0 * 32 + L.r32] + g * o[d0][r];
                OALL[gr * DM + 1024 + hd * 128 + d0 * 32 + L.r32] = f2bf(v); } }
    }
}
}
__device__ __forceinline__ f32x4 mma16(bf16x8 a, bf16x8 b, f32x4 c) { return __builtin_amdgcn_mfma_f32_16x16x32_bf16(a, b, c, 0, 0, 0); }

#define HG_CUMSUM(GSUM)                                                                                                                        \
    bf16_t flr[16];                                                                                                                            \
    _Pragma("unroll") for (int i = 0; i < 16; ++i) flr[i] = Pc[(size_t)(rg * 16 + i) * NP + C_HF + h * 128 + col];                             \
    HG_CUMSUM_PRE(GSUM)
#define HG_CUMSUM_PRE(GSUM)                                                                                                                    \
    float bc[16], kk[16]; float run = 0.f;                                                                                                     \
    _Pragma("unroll") for (int i = 0; i < 16; ++i) {                                                                                           \
        const float fl = bf2f(flr[i]); const float f = lb + (1.f - lb) * sigmoidf_(fl);                                                        \
        run += __logf(f); bc[i] = run; kk[i] = 1.f - f; }                                                                                      \
    GSUM[rg * 128 + col] = run; __syncthreads();                                                                                               \
    float pre = 0.f, total = 0.f;                                                                                                              \
    _Pragma("unroll") for (int g2 = 0; g2 < 4; ++g2) { const float gs = GSUM[g2 * 128 + col]; total += gs; if (g2 < rg) pre += gs; }           \
    _Pragma("unroll") for (int i = 0; i < 16; ++i) bc[i] += pre;

__device__ __forceinline__ void hgrn_local(const Frame& F, int layer, int it0, int it1, int its, unsigned* qctr) {
    LAS unsigned char* lds = F.lds;
    LAS bf16_t* kT = (LAS bf16_t*)lds; LAS bf16_t* vT = (LAS bf16_t*)(lds + 18432); LAS float* GS = (LAS float*)(lds + 36864);
    const bf16_t* P = (const bf16_t*)(F.ws + WS_P); bf16_t* HST = (bf16_t*)(F.ws + WS_HST); float* HD = (float*)(F.ws + WS_HD);
    const float* LB = (const float*)(F.ws + WS_TAB) + TAB_LB / 4 + layer * 512;
    const int col = F.tid & 127, rg = F.tid >> 7, r = F.lane & 15, q = F.lane >> 4;
    bf16_t vr[16], flr[16];
#define HGL_LOAD_ROWS(item_) do { const int bh_ = (item_) >> 8, c_ = (item_) & 255, b_ = bh_ >> 2, h_ = bh_ & 3; const bf16_t* Pn_ = P + ((size_t)b_ * SEQ + c_ * 64) * NP;      \
        _Pragma("unroll") for (int i = 0; i < 16; ++i) { const bf16_t* rowp = Pn_ + (size_t)(rg * 16 + i) * NP; vr[i] = rowp[C_HI + h_ * 128 + col]; flr[i] = rowp[C_HF + h_ * 128 + col]; } } while (0)
    if (it0 < it1) HGL_LOAD_ROWS(it0);
    int qn = 0;
    for (int item = it0; item < it1; item += its) {
        if (item + its >= it1) qn = q_issue(F, qctr);
        const int bh = item >> 8, h = bh & 3;
        const float lb = LB[h * 128 + col];
        HG_CUMSUM_PRE(GS)
#pragma unroll
        for (int i = 0; i < 16; ++i) { const int t = rg * 16 + i;
            kT[col * 72 + t] = f2bf(kk[i] * __expf(total - bc[i]));
            vT[col * 72 + t] = vr[i]; }
        if (rg == 0) HD[(size_t)item * 128 + col] = __expf(total);
        if (item + its < it1) HGL_LOAD_ROWS(item + its);
        __syncthreads();
        {   const int w = F.wave;
            bf16x8 a0 = *(const LAS bf16x8*)(vT + (16 * w + r) * 72 + q * 8), a1 = *(const LAS bf16x8*)(vT + (16 * w + r) * 72 + 32 + q * 8);
#pragma unroll
            for (int kt8 = 0; kt8 < 8; ++kt8) {
                f32x4 acc = (f32x4){0.f, 0.f, 0.f, 0.f};
                acc = mma16(a0, *(const LAS bf16x8*)(kT + (16 * kt8 + r) * 72 + q * 8), acc);
                acc = mma16(a1, *(const LAS bf16x8*)(kT + (16 * kt8 + r) * 72 + 32 + q * 8), acc);
#pragma unroll
                for (int i = 0; i < 4; ++i) HST[(size_t)item * 16384 + (16 * w + 4 * q + i) * 128 + 16 * kt8 + r] = f2bf(acc[i] * 1.0f);
            } }
        __syncthreads();
    }
    q_post(F, qn);
}
#undef HGL_LOAD_ROWS
__device__ __forceinline__ void hgrn_scan(const Frame& F) {
    bf16_t* HST = (bf16_t*)(F.ws + WS_HST); const float* HD = (const float*)(F.ws + WS_HD);
    for (int idx = F.wg * NTHREADS + F.tid; idx < 8 * 16384; idx += F.G * NTHREADS) {
        const int bh = idx >> 14, e = idx & 16383, kc = e & 127;
        bf16_t* hp = HST + (size_t)bh * 256 * 16384 + e; const float* dp = HD + (size_t)bh * 256 * 128 + kc;
        float state = 0.f; float d[8], dn[8]; bf16_t u[8], un[8];
#pragma unroll
        for (int j = 0; j < 8; ++j) { u[j] = hp[(size_t)j * 16384]; d[j] = dp[(size_t)j * 128]; }
        for (int c = 0; c < 256; c += 8) {
            const int cn = (c + 8 < 256) ? c + 8 : c;
#pragma unroll
            for (int j = 0; j < 8; ++j) { un[j] = hp[(size_t)(cn + j) * 16384]; dn[j] = dp[(size_t)(cn + j) * 128]; }
#pragma unroll
            for (int j = 0; j < 8; ++j) { hp[(size_t)(c + j) * 16384] = f2bf(state); state = d[j] * state + bf2f(u[j]); }
#pragma unroll
            for (int j = 0; j < 8; ++j) { u[j] = un[j]; d[j] = dn[j]; }
        }
    }
}
__device__ __forceinline__ void hgrn_out(const Frame& F, int layer, int it0, int it1, int its, unsigned* qctr) {
    LAS unsigned char* lds = F.lds;
    LAS float* bL = (LAS float*)lds;
    LAS bf16_t* qL = (LAS bf16_t*)(lds + 33024);
    LAS bf16_t* kL = (LAS bf16_t*)(lds + 50432);
    LAS bf16_t* qS = (LAS bf16_t*)(lds + 67840);
    LAS bf16_t* sT = (LAS bf16_t*)(lds + 85248);
    LAS bf16_t* stg = (LAS bf16_t*)(lds + 85248);
    LAS bf16_t* vT = (LAS bf16_t*)(lds + 120064);
    LAS bf16_t* sc = (LAS bf16_t*)(lds + 138496);
    LAS float* GS = (LAS float*)(lds + 147712);
    LAS float* oL = (LAS float*)lds;
    const bf16_t* P = (const bf16_t*)(F.ws + WS_P); const bf16_t* HST = (const bf16_t*)(F.ws + WS_HST); bf16_t* OALL = (bf16_t*)(F.ws + WS_OALL);
    const float* LB = (const float*)(F.ws + WS_TAB) + TAB_LB / 4 + layer * 512; const float* nw = F.inp(6) + layer * 128;
    const int col = F.tid & 127, rg = F.tid >> 7, r = F.lane & 15, q = F.lane >> 4;
    u32x4 st4[4];
    bf16_t qr[16], vr[16], flr[16];
#define HGO_LOAD_ROWS(item_) do { const int bh_ = (item_) >> 8, c_ = (item_) & 255, b_ = bh_ >> 2, h_ = bh_ & 3; const bf16_t* Pn_ = P + ((size_t)b_ * SEQ + c_ * 64) * NP;      \
        int rg_ = rg; asm volatile("" : "+v"(rg_));                                                \
        _Pragma("unroll") for (int i = 0; i < 16; ++i) { const bf16_t* rowp = Pn_ + (size_t)(rg_ * 16 + i) * NP; qr[i] = rowp[C_HQ + h_ * 128 + col]; vr[i] = rowp[C_HI + h_ * 128 + col]; \
            flr[i] = rowp[C_HF + h_ * 128 + col]; } } while (0)
#define HGO_LOAD_STATE(item_) do { _Pragma("unroll") for (int j = 0; j < 4; ++j) st4[j] = *(const u32x4*)(HST + (size_t)(item_) * 16384 + (j * NTHREADS + F.tid) * 8); } while (0)
    if (it0 < it1) { HGO_LOAD_STATE(it0); HGO_LOAD_ROWS(it0); }
    int qn = 0;
    for (int item = it0; item < it1; item += its) {
        if (item + its >= it1) qn = q_issue(F, qctr);
        const int bh = item >> 8, c = item & 255, b = bh >> 2, h = bh & 3;
        const float lb = LB[h * 128 + col];
        for (int i = F.tid; i < 64 * 72 / 2; i += NTHREADS) ((LAS unsigned*)sc)[i] = 0u;
        HG_CUMSUM_PRE(GS)
        (void)total;
#pragma unroll
        for (int i = 0; i < 16; ++i) { const int t = rg * 16 + i;
            const float qv = siluf_(bf2f(qr[i]));
            bL[t * 129 + col] = bc[i]; qL[t * 136 + col] = f2bf(qv); kL[t * 136 + col] = f2bf(kk[i]); qS[t * 136 + col] = f2bf(qv * __expf(bc[i]));
            vT[col * 72 + t] = vr[i]; }
        if (item + its < it1) HGO_LOAD_ROWS(item + its);
        __syncthreads();
        if (F.tid < 320) {
            const int task = F.tid, kq = task & 7, sb = (task >> 3) % 10, db = (task >> 3) / 10;
            const int bt = sb < 1 ? 0 : (sb < 3 ? 1 : (sb < 6 ? 2 : 3)), bs = sb - bt * (bt + 1) / 2;
            const int t0 = db * 16 + bt * 4, s0 = db * 16 + bs * 4;
            float a[4][4];
#pragma unroll
            for (int i = 0; i < 4; ++i)
#pragma unroll
                for (int j = 0; j < 4; ++j) a[i][j] = 0.f;
            for (int k2 = 0; k2 < 16; ++k2) { const int k = kq * 16 + k2;
                float qv[4], bq[4], kv[4], bk[4];
#pragma unroll
                for (int i = 0; i < 4; ++i) { qv[i] = bf2f(qL[(t0 + i) * 136 + k]); bq[i] = bL[(t0 + i) * 129 + k]; kv[i] = bf2f(kL[(s0 + i) * 136 + k]); bk[i] = bL[(s0 + i) * 129 + k]; }
#pragma unroll
                for (int i = 0; i < 4; ++i)
#pragma unroll
                    for (int j = 0; j < 4; ++j) a[i][j] += qv[i] * kv[j] * __expf(fminf(bq[i] - bk[j], 0.f)); }
#pragma unroll
            for (int i = 0; i < 4; ++i)
#pragma unroll
                for (int j = 0; j < 4; ++j) { float v = a[i][j]; v += __shfl_xor(v, 1); v += __shfl_xor(v, 2); v += __shfl_xor(v, 4); a[i][j] = v; }
            if (kq == 0) {
#pragma unroll
                for (int i = 0; i < 4; ++i)
#pragma unroll
                    for (int j = 0; j < 4; ++j) sc[(t0 + i) * 72 + s0 + j] = f2bf((s0 + j <= t0 + i) ? a[i][j] : 0.f);
            }
        }
        __syncthreads();
#pragma unroll 1
        for (int i = 1; i < 4; ++i) {
            const int nrow = 16 + 16 * i;
            for (int e = F.tid; e < nrow * 128; e += NTHREADS) { const int rr = e >> 7, k = e & 127;
                const float ref = bL[(16 * i - 1) * 129 + k];
                float v;
                if (rr < 16) { const int t = 16 * i + rr; v = bf2f(qL[t * 136 + k]) * __expf(bL[t * 129 + k] - ref); }
                else { const int s2 = rr - 16; v = bf2f(kL[s2 * 136 + k]) * __expf(ref - bL[s2 * 129 + k]); }
                stg[rr * 136 + k] = f2bf(v); }
            __syncthreads();
            if (F.wave < i) { const int j = F.wave; f32x4 acc = (f32x4){0.f, 0.f, 0.f, 0.f};
#pragma unroll
                for (int ks = 0; ks < 4; ++ks) acc = mma16(*(const LAS bf16x8*)(stg + r * 136 + ks * 32 + q * 8), *(const LAS bf16x8*)(stg + (16 + 16 * j + r) * 136 + ks * 32 + q * 8), acc);
#pragma unroll
                for (int ii = 0; ii < 4; ++ii) sc[(16 * i + 4 * q + ii) * 72 + 16 * j + r] = f2bf(acc[ii]); }
            __syncthreads();
        }
#pragma unroll
        for (int j = 0; j < 4; ++j) { const int i8 = (j * NTHREADS + F.tid) * 8; *(LAS u32x4*)(sT + (i8 >> 7) * 136 + (i8 & 127)) = st4[j]; }
        if (item + its < it1) HGO_LOAD_STATE(item + its);
        __syncthreads();
        f32x4 acc[4];
        {   const int tt = F.wave & 3, vg = F.wave >> 2;
#pragma unroll
            for (int j = 0; j < 4; ++j) acc[j] = (f32x4){0.f, 0.f, 0.f, 0.f};
#pragma unroll
            for (int ks = 0; ks < 4; ++ks) { const bf16x8 a = *(const LAS bf16x8*)(qS + (16 * tt + r) * 136 + ks * 32 + q * 8);
#pragma unroll
                for (int j = 0; j < 4; ++j) acc[j] = mma16(a, *(const LAS bf16x8*)(sT + (16 * (vg * 4 + j) + r) * 136 + ks * 32 + q * 8), acc[j]); }
#pragma unroll
            for (int ks = 0; ks < 2; ++ks) { const bf16x8 a = *(const LAS bf16x8*)(sc + (16 * tt + r) * 72 + ks * 32 + q * 8);
#pragma unroll
                for (int j = 0; j < 4; ++j) acc[j] = mma16(a, *(const LAS bf16x8*)(vT + (16 * (vg * 4 + j) + r) * 72 + ks * 32 + q * 8), acc[j]); }
#pragma unroll
            for (int j = 0; j < 4; ++j)
#pragma unroll
                for (int i = 0; i < 4; ++i) oL[(16 * tt + 4 * q + i) * 132 + 16 * (vg * 4 + j) + r] = acc[j][i];
        }
        __syncthreads();
        {   const int t = F.tid >> 3, seg = F.tid & 7; float v[16]; float ss = 0.f;
#pragma unroll
            for (int j = 0; j < 16; ++j) { v[j] = oL[t * 132 + seg * 16 + j]; ss += v[j] * v[j]; }
            ss += __shfl_xor(ss, 1); ss += __shfl_xor(ss, 2); ss += __shfl_xor(ss, 4);
            const float rs = rsqrtf(ss * (1.f / 128.f) + 1e-6f);
            const size_t grow = (size_t)b * SEQ + c * 64 + t;
            const bf16_t* gp = P + grow * NP + C_HG + h * 128 + seg * 16;
            const u32x4 g0 = *(const u32x4*)gp, g1 = *(const u32x4*)(gp + 8);
            float gv[16];
#pragma unroll
            for (int j = 0; j < 4; ++j) { gv[2 * j] = bflo(g0[j]); gv[2 * j + 1] = bfhi(g0[j]); gv[8 + 2 * j] = bflo(g1[j]); gv[8 + 2 * j + 1] = bfhi(g1[j]); }
            float o16[16];
#pragma unroll
            for (int j = 0; j < 16; ++j) o16[j] = v[j] * rs * nw[seg * 16 + j] * siluf_(gv[j]);
            bf16_t* op = OALL + grow * DM + h * 128 + seg * 16;
            *(u32x4*)op = (u32x4){cvtpk(o16[0], o16[1]), cvtpk(o16[2], o16[3]), cvtpk(o16[4], o16[5]), cvtpk(o16[6], o16[7])};
            *(u32x4*)(op + 8) = (u32x4){cvtpk(o16[8], o16[9]), cvtpk(o16[10], o16[11]), cvtpk(o16[12], o16[13]), cvtpk(o16[14], o16[15])};
        }
        __syncthreads();
    }
    q_post(F, qn);
}
#undef HGO_LOAD_ROWS
#undef HGO_LOAD_STATE
__device__ __forceinline__ void gmlp_phase(const Frame& F, int layer, int it0, int it1, int its) {
    LAS unsigned char* lds = F.lds;
    LAS bf16_t* vnT = (LAS bf16_t*)lds;
    LAS float* vmL = (LAS float*)(lds + 34816);
    const bf16_t* P = (const bf16_t*)(F.ws + WS_P); bf16_t* OALL = (bf16_t*)(F.ws + WS_OALL);
    const bf16_t* GMW = (const bf16_t*)(F.ws + WS_GMW) + (size_t)layer * 4 * 128 * 128;
    const float* lnw = F.inp(18) + layer * 512; const float* lnb = F.inp(19) + layer * 512; const float* bs = F.inp(21) + layer * 512;
    const int t = F.tid >> 2, q4 = F.tid & 3, r = F.lane & 15, q = F.lane >> 4, w = F.wave;
    for (int item = it0; item < it1; item += its) {
        const size_t row0 = (size_t)item * 128;
        const bf16_t* zr = P + (row0 + t) * NP + C_GZ;
        float sum = 0.f, sq = 0.f;
#pragma unroll
        for (int j = 0; j < 128; j += 8) { const u32x4 zz = *(const u32x4*)(zr + 512 + q4 * 128 + j);
#pragma unroll
            for (int e = 0; e < 4; ++e) { const float g0 = gelu_tanh(bflo(zz[e])), g1 = gelu_tanh(bfhi(zz[e])); sum += g0 + g1; sq += g0 * g0 + g1 * g1; } }
        sum += __shfl_xor(sum, 1); sum += __shfl_xor(sum, 2); sq += __shfl_xor(sq, 1); sq += __shfl_xor(sq, 2);
        const float mean = sum * (1.f / 512.f), var = fmaxf(sq * (1.f / 512.f) - mean * mean, 0.f), rstd = rsqrtf(var + 1e-5f);
        for (int g = 0; g < 4; ++g) {
#pragma unroll
            for (int j = 0; j < 32; j += 8) { const int cc = g * 128 + q4 * 32 + j; const u32x4 zz = *(const u32x4*)(zr + 512 + cc);
#pragma unroll
                for (int e = 0; e < 4; ++e) {
                    const float v0 = (gelu_tanh(bflo(zz[e])) - mean) * rstd * lnw[cc + 2 * e] + lnb[cc + 2 * e];
                    const float v1 = (gelu_tanh(bfhi(zz[e])) - mean) * rstd * lnw[cc + 2 * e + 1] + lnb[cc + 2 * e + 1];
                    vnT[(q4 * 32 + j + 2 * e) * 136 + t] = f2bf(v0); vnT[(q4 * 32 + j + 2 * e + 1) * 136 + t] = f2bf(v1); } }
            __syncthreads();
            f32x4 acc[8];
#pragma unroll
            for (int dt = 0; dt < 8; ++dt) acc[dt] = (f32x4){0.f, 0.f, 0.f, 0.f};
#pragma unroll
            for (int ks = 0; ks < 4; ++ks) { const bf16x8 a = *(const bf16x8*)(GMW + ((size_t)g * 128 + 16 * w + r) * 128 + ks * 32 + q * 8);
#pragma unroll
                for (int dt = 0; dt < 8; ++dt) acc[dt] = mma16(a, *(const LAS bf16x8*)(vnT + (16 * dt + r) * 136 + ks * 32 + q * 8), acc[dt]); }
#pragma unroll
            for (int i = 0; i < 4; ++i) { const int tt = 16 * w + 4 * q + i; const float bias = bs[g * 128 + tt];
#pragma unroll
                for (int dt = 0; dt < 8; ++dt) vmL[tt * 132 + 16 * dt + r] = acc[dt][i] + bias; }
            __syncthreads();
            {   const bf16_t* up = P + (row0 + t) * NP + C_GZ + g * 128 + q4 * 32; bf16_t* op = OALL + (row0 + t) * DM + 1536 + g * 128 + q4 * 32;
                u32x4 uu[4];
#pragma unroll
                for (int j = 0; j < 4; ++j) uu[j] = *(const u32x4*)(up + 8 * j);
#pragma unroll
                for (int j = 0; j < 4; ++j) { const f32x4 v0 = *(const LAS f32x4*)(vmL + t * 132 + q4 * 32 + 8 * j), v1 = *(const LAS f32x4*)(vmL + t * 132 + q4 * 32 + 8 * j + 4);
                    *(u32x4*)(op + 8 * j) = (u32x4){cvtpk(gelu_tanh(bflo(uu[j][0])) * v0[0], gelu_tanh(bfhi(uu[j][0])) * v0[1]), cvtpk(gelu_tanh(bflo(uu[j][1])) * v0[2], gelu_tanh(bfhi(uu[j][1])) * v0[3]),
                                                  cvtpk(gelu_tanh(bflo(uu[j][2])) * v1[0], gelu_tanh(bfhi(uu[j][2])) * v1[1]), cvtpk(gelu_tanh(bflo(uu[j][3])) * v1[2], gelu_tanh(bfhi(uu[j][3])) * v1[3])}; }
            }
            __syncthreads();
        }
    }
}
constexpr int NLP = 21, PH_LAYER0 = 3, PH_FINAL = PH_LAYER0 + NLP * DEPTH, NPH = PH_FINAL + 1;
struct Args { const float* in[32]; float* out; unsigned char* ws; int ph_lo, ph_hi; };

__global__ void __launch_bounds__(NTHREADS, 2) fwd_kernel(Args args) {
    extern __shared__ __attribute__((aligned(16))) unsigned char lds_raw[];
    Frame F0;
    F0.in = (const float* const __attribute__((address_space(4)))*)__builtin_amdgcn_kernarg_segment_ptr();
    F0.out = args.out; F0.ws = args.ws; F0.lds = (LAS unsigned char*)lds_raw;
    F0.wave = __builtin_amdgcn_readfirstlane((int)(threadIdx.x >> 6)); F0.lane = lane_id(); F0.tid = F0.wave * 64 + F0.lane; F0.G = gridDim.x; F0.wg = blockIdx.x;
    const int lo = args.ph_lo, hi = args.ph_hi;
    if (F0.tid == 0) *(LAS u32x4*)(F0.lds + LDS_BARW) = (u32x4){0u, 0u, 0u, 0u};
    __syncthreads();
    XcdBarrier bar; bar.bar = (unsigned*)(F0.ws + WS_CTL); bar.x = 0; bar.st = nullptr; bar.w0 = (F0.wave == 0);
    if (hi - lo > 1) bar = xcd_barrier_post((unsigned*)(F0.ws + WS_CTL), (volatile LAS unsigned*)(F0.lds + LDS_BARW), F0.wave == 0);
#ifndef PHSEL
#define PHSEL(t) true
#endif
#define IN(k) (lo <= (k) && (k) < hi)
#ifdef PROBE_DOUBLE_BARRIER
#define SEAM(k) do { if (IN(k) && IN((k) + 1)) { xcd_barrier(bar); xcd_barrier(bar); } } while (0)
#else
#define SEAM(k) do { if (IN(k) && IN((k) + 1)) xcd_barrier(bar); } while (0)
#endif
#define PHASE_FRAME Frame F = F0; { int t_; asm volatile("v_mbcnt_lo_u32_b32 %0, -1, 0\n\tv_mbcnt_hi_u32_b32 %0, -1, %0" : "=v"(t_)); t_ += F0.wave * 64; asm volatile("" : "+v"(t_)); F.tid = t_; F.lane = t_ & 63; F.wave = __builtin_amdgcn_readfirstlane(t_ >> 6); \
        size_t z_ = 0; asm volatile("" : "+s"(z_));     \
        F.ws = (unsigned char*)((GAS unsigned char*)F0.ws + z_); F.out = (float*)((GAS float*)F0.out + z_); \
        int g_ = F.wg; asm volatile("" : "+s"(g_)); F.wg = g_; } unsigned char* const ws = F.ws; (void)ws;

    if (PHSEL(0) && IN(0)) { PHASE_FRAME p0_prologue(F); SEAM(0); }
    if (PHSEL(1) && IN(1)) { PHASE_FRAME
        pg8::SchedKV S{F.G, F.wg, 2048, 2048, (const char*)(ws + WS_MEMN), (const char*)(ws + WS_WKVT)};
        pg8::EpiGen E{(bf16_t*)(ws + WS_KV), nullptr, 4096, 0, 1.f, 0};
        pg8::gemm_phase<pg8::EpiGen, pg8::SchedKV>(F.lds, F.tid, S, E);
        SEAM(1);
    }
    if (PHSEL(2) && IN(2)) { PHASE_FRAME
        {   pg8::SchedWQK S{F.G, F.wg, 4096, 2048, (const char*)(ws + WS_KV), (const char*)(ws + WS_WQB)};
            pg8::EpiGen E{(bf16_t*)(ws + WS_WQK), nullptr, 2048, 2, 0.044194173824159216f * GATE_WSCALE, 0};
            pg8::gemm_phase<pg8::EpiGen, pg8::SchedWQK>(F.lds, F.tid, S, E); }
        {   pg8::SchedVWO S{F.G, F.wg, 2048, 4096, (const char*)(ws + WS_WOT), (const char*)(ws + WS_KV)};
            pg8::EpiGen E{(bf16_t*)(ws + WS_VWO), nullptr, 1024, 2, GATE_WSCALE, 0};
            pg8::gemm_phase<pg8::EpiGen, pg8::SchedVWO>(F.lds, F.tid, S, E); }
        SEAM(2);
    }
    for (int l = 0; l < DEPTH; ++l) {
        const int pb = PH_LAYER0 + NLP * l;
        if (PHSEL(4) && IN(pb + 1)) { PHASE_FRAME
            pg8::SchedStd S{128, 24, F.G, F.wg, 32, 2048, 2048, (const char*)(ws + WS_H), (const char*)(ws + WS_WIN) + (size_t)l * NP * DM * 2, 0};
            pg8::EpiInProj E{(bf16_t*)(ws + WS_P), (bf16_t*)(ws + WS_CK), (bf16_t*)(ws + WS_CV), (const float*)(ws + WS_SS), F.lds};
            pg8::gemm_phase<pg8::EpiInProj, pg8::SchedStd>(F.lds, F.tid, S, E);
            SEAM(pb + 1);
        }
        if (PHSEL(5) && IN(pb + 2)) { PHASE_FRAME
            unsigned* ctr = (unsigned*)(ws + WS_CTL + 16384) + (l * 4 + 0) * 64;
            int it = q_next(F, ctr);
            while (it < 1024) { { int t_ = F.tid; asm volatile("" : "+v"(t_)); F.tid = t_; } at::diff_attn_item(F, l, it & 7, 127 - (it >> 3), ctr); it = q_read(F); }
            while (it < 1040) { { int t_ = F.tid; asm volatile("" : "+v"(t_)); F.tid = t_; }
                pg8::SchedCmpOne S{it - 1024, 2048, 4096, (const char*)(ws + WS_CK), (const char*)(ws + WS_CW1) + (size_t)l * 2 * 256 * 4096 * 2};
                pg8::EpiGen E{(bf16_t*)(ws + WS_HC), (const float*)(ws + WS_TAB) + TAB_CBIAS / 4 + l * 512, 256, 1, 1.f, 0};
                pg8::gemm_phase<pg8::EpiGen, pg8::SchedCmpOne>(F.lds, F.tid, S, E); it = q_next(F, ctr); }
            while (it < 1296) { { int t_ = F.tid; asm volatile("" : "+v"(t_)); F.tid = t_; } gmlp_phase(F, l, it - 1040, it - 1039, 1); it = q_next(F, ctr); }
            while (it < 1808) { { int t_ = F.tid; asm volatile("" : "+v"(t_)); F.tid = t_; } hgrn_local(F, l, (it - 1296) * 4, (it - 1296) * 4 + 4, 1, ctr); it = q_read(F); }
            SEAM(pb + 2); }
        if (PHSEL(6) && IN(pb + 3)) { PHASE_FRAME hgrn_scan(F); compress2(F, l); SEAM(pb + 3); }
        if (PHSEL(7) && IN(pb + 4)) { PHASE_FRAME
            unsigned* ctr = (unsigned*)(ws + WS_CTL + 16384) + (l * 4 + 1) * 64;
            int it = q_next(F, ctr);
            while (it < 512) { { int t_ = F.tid; asm volatile("" : "+v"(t_)); F.tid = t_; } at::nsa_item(F, it & 1, 255 - (it >> 1)); it = q_next(F, ctr); }
            while (it < 1024) { { int t_ = F.tid; asm volatile("" : "+v"(t_)); F.tid = t_; } hgrn_out(F, l, (it - 512) * 4, (it - 512) * 4 + 4, 1, ctr); it = q_read(F); }
            SEAM(pb + 4); }
        if (PHSEL(15) && IN(pb + 12)) { PHASE_FRAME
            pg8::SchedMerge S{F.G, F.wg, 2048, 2048, (const char*)(ws + WS_WG + 2048), (const char*)(ws + WS_OALL),
                              (const char*)(ws + WS_WG) + (size_t)l * 8192 * DM * 2, (const char*)(ws + WS_WB) + (size_t)l * DM * DM * 2};
            pg8::EpiMerge E{(bf16_t*)(ws + WS_GSCR + (size_t)F.wg * 131072), (bf16_t*)(ws + WS_MACC + (size_t)F.wg * 131072), (bf16_t*)(ws + WS_MRG), (const float*)(ws + WS_SS), F.lds};
            if ((F.wg >> 3) & 1) { for (int i = 0; i < 5; ++i) __builtin_amdgcn_s_sleep(127); }
            pg8::gemm_phase<pg8::EpiMerge, pg8::SchedMerge>(F.lds, F.tid, S, E);
            SEAM(pb + 12);
        }
        if (PHSEL(16) && IN(pb + 13)) { PHASE_FRAME
            pg8::SchedStd S{128, 8, F.G, F.wg, 32, 2048, 2048, (const char*)(ws + WS_MRG), (const char*)(ws + WS_WO) + (size_t)l * DM * DM * 2, 0};
            pg8::EpiResid E{(bf16_t*)(ws + WS_H), (float*)(ws + WS_SS), (LAS float*)(F.lds + 131072), ws + WS_WG + 2048, 1.f, 0};
            pg8::gemm_phase<pg8::EpiResid, pg8::SchedStd>(F.lds, F.tid, S, E);
            SEAM(pb + 13);
        }
        if (PHSEL(18) && IN(pb + 15)) { PHASE_FRAME
            pg8::SchedStd8 S{128, 4, F.G, F.wg, 16, 2048, 1024, (const char*)(ws + WS_WG + 2048), (const char*)(ws + WS_WQK) + (size_t)l * 2 * 1024 * 2048, 1024ull * 2048};
            pg8::EpiXaSoftmax E{(bf16_t*)(ws + WS_PXA), (const float*)(ws + WS_SS), F.lds};
            pg8::gemm_phase<pg8::EpiXaSoftmax, pg8::SchedStd8>(F.lds, F.tid, S, E);
            SEAM(pb + 15);
        }
        if (PHSEL(20) && IN(pb + 17)) { PHASE_FRAME
            pg8::SchedStd8 S{128, 8, F.G, F.wg, 8, 512, 512, (const char*)(ws + WS_PXA), (const char*)(ws + WS_VWO) + (size_t)l * 2 * 2048 * 1024, 2048ull * 1024};
            pg8::EpiResid E{(bf16_t*)(ws + WS_H), (float*)(ws + WS_SS), (LAS float*)(F.lds + 131072), nullptr, 1.f / (XA_PSCALE * GATE_WSCALE), 0};
            pg8::gemm_phase<pg8::EpiResid, pg8::SchedStd8>(F.lds, F.tid, S, E);
            SEAM(pb + 17);
        }
        if (PHSEL(22) && IN(pb + 19)) { PHASE_FRAME
            pg8::SchedStd S{128, 44, F.G, F.wg, 32, 2048, 2048, (const char*)(ws + WS_H), (const char*)(ws + WS_FF1) + (size_t)l * 2 * DFF * DM * 2, 0};
            pg8::EpiFfn1 E{(bf16_t*)(ws + WS_HID), (const float*)(ws + WS_SS), F.lds};
            pg8::gemm_phase<pg8::EpiFfn1, pg8::SchedStd>(F.lds, F.tid, S, E);
            SEAM(pb + 19);
        }
        if (PHSEL(23) && IN(pb + 20)) { PHASE_FRAME
            pg8::SchedStd S{128, 8, F.G, F.wg, 88, 5632, 5632, (const char*)(ws + WS_HID), (const char*)(ws + WS_FF2) + (size_t)l * DM * DFF * 2, 0};
            pg8::EpiResid E{(bf16_t*)(ws + WS_H), (float*)(ws + WS_SS), (LAS float*)(F.lds + 131072), (l + 1 < DEPTH) ? ws + WS_WG + 2048 : nullptr, 1.f, 0};
            pg8::gemm_phase<pg8::EpiResid, pg8::SchedStd>(F.lds, F.tid, S, E);
            SEAM(pb + 20);
        }
    }
    if (PHSEL(24) && IN(PH_FINAL)) { PHASE_FRAME final_norm(F, F.out, F.inp(31), (const float*)(ws + WS_SS)); }
#undef IN
#undef SEAM
}

extern "C" void kernel_launch(void* const* d_in, const int* in_sizes, int n_in, void* d_out, int out_size, void* d_ws, size_t ws_size, hipStream_t stream) {
    static int grid = 0;
    if (grid == 0) {
        if (n_in != 32 || in_sizes[0] != MT * DM || out_size != MT * DM || ws_size < WS_END) {
            fprintf(stderr, "kernel_launch: unexpected shapes (n_in %d, in0 %d, out %d, ws %zu, need %zu); nothing launched\n", n_in, n_in > 0 ? in_sizes[0] : -1, out_size, ws_size, (size_t)WS_END);
            grid = -1; return; }
        int dev = 0, cus = 0, per_cu = 0;
        if (hipGetDevice(&dev) != hipSuccess || hipDeviceGetAttribute(&cus, hipDeviceAttributeMultiprocessorCount, dev) != hipSuccess) { grid = -1; return; }
        if (hipFuncSetAttribute((const void*)fwd_kernel, hipFuncAttributeMaxDynamicSharedMemorySize, LDS_BYTES) != hipSuccess) { fprintf(stderr, "kernel_launch: hipFuncSetAttribute failed\n"); grid = -1; return; }
        if (hipOccupancyMaxActiveBlocksPerMultiprocessor(&per_cu, (const void*)fwd_kernel, NTHREADS, LDS_BYTES) != hipSuccess || per_cu < 1)
            fprintf(stderr, "kernel_launch: note: occupancy query reports %d workgroups per CU\n", per_cu);
        (void)hipGetLastError();
        grid = cus;
    }
    if (grid < 0) return;
    (void)hipMemsetAsync((char*)d_ws + WS_CTL, 0, 65536, stream);
    Args a{};
    for (int i = 0; i < 32; ++i) a.in[i] = (const float*)d_in[i];
    a.out = (float*)d_out; a.ws = (unsigned char*)d_ws;
#if MK_N_LAUNCHES == 1
    a.ph_lo = 0; a.ph_hi = NPH;
    hipLaunchKernelGGL(fwd_kernel, dim3(grid), dim3(NTHREADS), LDS_BYTES, stream, a);
#else
    auto run = [&](int p) { a.ph_lo = p; a.ph_hi = p + 1; hipLaunchKernelGGL(fwd_kernel, dim3(grid), dim3(NTHREADS), LDS_BYTES, stream, a); };
    for (int p = 0; p < PH_FINAL; ++p) run(p);
    run(PH_FINAL);
#endif
}
```

```cpp
#include <hip/hip_runtime.h>
#include <cstdio>
#include <cstdint>

#ifndef MK_N_LAUNCHES
#define MK_N_LAUNCHES 1
#endif

#define LAS __attribute__((address_space(3)))
typedef unsigned short bf16_t;
typedef short bf16x8 __attribute__((ext_vector_type(8)));
typedef short s16x4 __attribute__((ext_vector_type(4)));
typedef float f32x4 __attribute__((ext_vector_type(4)));
typedef float f32x2 __attribute__((ext_vector_type(2)));
typedef float f32x16 __attribute__((ext_vector_type(16)));
typedef unsigned u32x4 __attribute__((ext_vector_type(4)));
typedef unsigned u32x2 __attribute__((ext_vector_type(2)));
typedef int i32x4 __attribute__((ext_vector_type(4)));
typedef int i32x8 __attribute__((ext_vector_type(8)));

constexpr int DM = 2048, NBATCH = 2, SEQ = 16384, MT = NBATCH * SEQ, DEPTH = 4, NMEM = 256, DFF = 5632;
constexpr int NIN = 14092, NP = 6144;
constexpr int C_HQ = 0, C_HF = 512, C_HI = 1024, C_HG = 1536, C_DQ = 2048, C_DK = 2560, C_DV = 3072, C_NQ = 3584,
              C_KC = 4096, C_VC = 4224, C_KS = 4352, C_VS = 4480, C_KW = 4608, C_VW = 4736, C_GZ = 4864, C_NG = 5888;
constexpr int NTHREADS = 512, LDS_BYTES = 163840 - 512;
constexpr int LDS_BARW = LDS_BYTES - 64;

constexpr size_t MiB = 1ull << 20;
constexpr size_t WS_CTL  = 0;
constexpr size_t WS_TAB  = 65536;
constexpr size_t TAB_LB = 0, TAB_LAM = 8192, TAB_CBIAS = 8448;
constexpr size_t WS_H    = 131072;
constexpr size_t WS_P    = WS_H + 128 * MiB;
constexpr size_t WS_CK   = WS_P + 384 * MiB;
constexpr size_t CKV_BYTES = (size_t)(MT + 64) * 128 * 2;
constexpr size_t WS_CV   = WS_CK + CKV_BYTES;
constexpr size_t WS_HC   = WS_CV + CKV_BYTES;
constexpr size_t WS_KC   = WS_HC + 2 * MiB;
constexpr size_t WS_VC   = WS_KC + 512 * 1024;
constexpr size_t WS_OALL = WS_VC + 512 * 1024;
constexpr size_t WS_HST  = WS_OALL + 128 * MiB;
constexpr size_t WS_HD   = WS_HST + 128 * MiB;
constexpr size_t WS_PSUM = WS_HD + 1 * MiB;
constexpr size_t WS_SEL  = WS_PSUM + 128 * MiB;
constexpr size_t WS_NACC = WS_SEL + 1 * MiB;
constexpr size_t WS_GSCR = WS_NACC + 64 * MiB;
constexpr size_t WS_MACC = WS_GSCR + 32 * MiB;
constexpr size_t WS_WIN  = WS_MACC + 64 * MiB;
constexpr size_t WS_WG   = WS_WIN + 96 * MiB;
constexpr float GATE_WSCALE = 64.f;
constexpr float XA_PSCALE = 256.f;
constexpr size_t WS_WB   = WS_WG + 128 * MiB;
constexpr size_t WS_WO   = WS_WB + 32 * MiB;
constexpr size_t WS_WQK  = WS_WO + 32 * MiB;
constexpr size_t WS_VWO  = WS_WQK + 32 * MiB;
constexpr size_t WS_FF1  = WS_VWO + 32 * MiB;
constexpr size_t WS_FF2  = WS_FF1 + 176 * MiB;
constexpr size_t WS_CW1  = WS_FF2 + 88 * MiB;
constexpr size_t WS_GMW  = WS_CW1 + 16 * MiB;
constexpr size_t WS_CW2  = WS_GMW + 512 * 1024;
constexpr size_t WS_SS   = WS_GMW + 1 * MiB;
constexpr size_t WS_END  = WS_SS + 1 * MiB;
constexpr size_t WS_WQB  = WS_P;
constexpr size_t WS_WOT  = WS_P + 32 * MiB;
constexpr size_t WS_WKVT = WS_P + 64 * MiB;
constexpr size_t WS_MEMN = WS_P + 128 * MiB;
constexpr size_t WS_KV   = WS_P + 130 * MiB;
constexpr size_t WS_MRG  = WS_P;
constexpr size_t WS_GS4  = WS_P + 128 * MiB;
constexpr size_t WS_S    = WS_P + 128 * MiB;
constexpr size_t WS_PXA  = WS_P + 256 * MiB;
constexpr size_t WS_HID  = WS_P;

#define XB_TMO      128
#define XB_XCNT(j)  (256  + 64 * (j))
#define XB_XSUB(j)  (1280 + 64 * (j))
#define XB_XGEN(j)  (2304 + 64 * (j))
#define XB_TOP      3328
#define XB_TOPGEN   3392
#define XCD_BAR_WORDS 3456
#define XB_SPIN_CAP (1u << 18)
__device__ __forceinline__ unsigned xb_ld(unsigned* p)              { return __hip_atomic_load(p, __ATOMIC_RELAXED, __HIP_MEMORY_SCOPE_AGENT); }
__device__ __forceinline__ unsigned xb_add(unsigned* p, unsigned v) { return __hip_atomic_fetch_add(p, v, __ATOMIC_RELAXED, __HIP_MEMORY_SCOPE_AGENT); }
__device__ __forceinline__ unsigned xb_xcc_id() { return (unsigned)__builtin_amdgcn_s_getreg((3 << 11) | 20) & 0xFu; }
#define XB_SPIN(cond, bar) do { unsigned _sp = 0; while (cond) { __builtin_amdgcn_s_sleep(1); \
    if ((++_sp & 255u) == 0u) { if (xb_ld(&(bar)[XB_TMO])) break; if (_sp > XB_SPIN_CAP) { atomicAdd(&(bar)[XB_TMO], 1u); break; } } } } while (0)
__device__ __forceinline__ int lane_id() { return (int)__builtin_amdgcn_mbcnt_hi(~0u, __builtin_amdgcn_mbcnt_lo(~0u, 0u)); }
struct XcdBarrier { unsigned* bar; unsigned x; volatile LAS unsigned* st; int w0; };
__device__ __forceinline__ XcdBarrier xcd_barrier_post(unsigned* bar, volatile LAS unsigned* st, int w0) {
    XcdBarrier b; b.bar = bar; b.x = xb_xcc_id(); b.st = st; b.w0 = w0;
    if (w0 && lane_id() == 0) (void)xb_add(&bar[XB_XCNT(b.x)], 1u);
    return b;
}
__device__ __forceinline__ void xcd_barrier_complete(unsigned* bar, unsigned x, unsigned& nloc, unsigned& nx) {
    const unsigned G = gridDim.x * gridDim.y * gridDim.z;
    unsigned sum, cnt, mine, sp = 0u;
    for (;;) {
        sum = 0u; cnt = 0u; mine = 0u;
#pragma unroll
        for (unsigned j = 0; j < 16; ++j) { const unsigned c = xb_ld(&bar[XB_XCNT(j)]); sum += c; cnt += (c > 0u) ? 1u : 0u; mine = (j == x) ? c : mine; }
        if (sum == G) break;
        __builtin_amdgcn_s_sleep(1);
        if ((++sp & 255u) == 0u) { if (xb_ld(&bar[XB_TMO])) break; if (sp > XB_SPIN_CAP) { atomicAdd(&bar[XB_TMO], 1u); break; } }
    }
    nloc = mine > 0u ? mine : 1u; nx = cnt > 0u ? cnt : 1u;
}
__device__ __forceinline__ void xcd_barrier(const XcdBarrier& b) {
    asm volatile("s_waitcnt vmcnt(0)" ::: "memory");
    __syncthreads();
    if (b.w0 && lane_id() == 0) {
        unsigned* bar = b.bar;
        __builtin_amdgcn_s_waitcnt(0);
        unsigned nloc = b.st[0], nx = b.st[1];
        if (nloc == 0u) { xcd_barrier_complete(bar, b.x, nloc, nx); b.st[0] = nloc; b.st[1] = nx; }
        const unsigned old = xb_add(&bar[XB_XSUB(b.x)], 1u);
        const unsigned gen = old / nloc;
        if (old + 1u == (gen + 1u) * nloc) {
            __builtin_amdgcn_fence(__ATOMIC_RELEASE, "agent");
            asm volatile("s_waitcnt vmcnt(0)" ::: "memory");
            const unsigned og = xb_add(&bar[XB_TOP], 1u);
            const unsigned tg = og / nx;
            if (og + 1u == (tg + 1u) * nx) xb_add(&bar[XB_TOPGEN], 1u);
            else XB_SPIN(xb_ld(&bar[XB_TOPGEN]) == tg, bar);
            __builtin_amdgcn_fence(__ATOMIC_ACQUIRE, "agent");
            xb_add(&bar[XB_XGEN(b.x)], 1u);
            asm volatile("s_waitcnt vmcnt(0)" ::: "memory");
        } else {
            XB_SPIN(xb_ld(&bar[XB_XGEN(b.x)]) == gen, bar);
            __builtin_amdgcn_fence(__ATOMIC_ACQUIRE, "agent");
            asm volatile("s_waitcnt vmcnt(0)" ::: "memory");
        }
    }
    __syncthreads();
}

typedef __bf16 bf16x2_t __attribute__((ext_vector_type(2)));
__device__ __forceinline__ unsigned cvtpk(float lo, float hi) { const f32x2 v = {lo, hi}; return __builtin_bit_cast(unsigned, __builtin_convertvector(v, bf16x2_t)); }
__device__ __forceinline__ unsigned cvt4_fp8(float a, float b, float c, float d) {
    a = __builtin_amdgcn_fmed3f(a, -448.f, 448.f); b = __builtin_amdgcn_fmed3f(b, -448.f, 448.f); c = __builtin_amdgcn_fmed3f(c, -448.f, 448.f); d = __builtin_amdgcn_fmed3f(d, -448.f, 448.f);
    int w = __builtin_amdgcn_cvt_pk_fp8_f32(a, b, 0, false); w = __builtin_amdgcn_cvt_pk_fp8_f32(c, d, w, true); return (unsigned)w;
}
__device__ __forceinline__ bf16_t f2bf(float f) { return (bf16_t)(cvtpk(f, 0.f) & 0xFFFFu); }
__device__ __forceinline__ float bf2f(bf16_t b) { return __uint_as_float(((unsigned)b) << 16); }
__device__ __forceinline__ float bflo(unsigned w) { return __uint_as_float(w << 16); }
__device__ __forceinline__ float bfhi(unsigned w) { return __uint_as_float(w & 0xFFFF0000u); }
__device__ __forceinline__ float sigmoidf_(float x) { return __builtin_amdgcn_rcpf(1.f + __expf(-x)); }
__device__ __forceinline__ float siluf_(float x) { return x * __builtin_amdgcn_rcpf(1.f + __expf(-x)); }
__device__ __forceinline__ float gelu_tanh(float x) {
    const float u = 0.7978845608028654f * (x + 0.044715f * x * x * x);
    const float e = __expf(2.f * u);
    const float th = 1.f - 2.f * __builtin_amdgcn_rcpf(e + 1.f);
    return 0.5f * x * (1.f + th);
}
__device__ __forceinline__ float wave_sum(float v) {
#pragma unroll
    for (int o = 32; o >= 1; o >>= 1) v += __shfl_xor(v, o);
    return v;
}
__device__ __forceinline__ float wave_max(float v) {
#pragma unroll
    for (int o = 32; o >= 1; o >>= 1) v = fmaxf(v, __shfl_xor(v, o));
    return v;
}

#define GAS __attribute__((address_space(1)))
struct Frame {
    const float* const __attribute__((address_space(4)))* in;
    __device__ __forceinline__ const float* inp(int i) const { return (const float*)(const GAS float*)in[i]; }
    float* out;
    unsigned char* ws;
    LAS unsigned char* lds;
    int tid, lane, wave, G, wg;
};
namespace pg8 {
constexpr int BM = 256, BK = 64, HALF = 128, HTB = HALF * BK * 2, STAGE_BYTES = 8 * HTB, NXCD = 8, WGM = 8;
__host__ __device__ __forceinline__ int lds_byte(int r, int c) { const int st = (r >> 4) * 2 + (c >> 5), rr = r & 15, cc = c & 31, ob = rr * 64 + cc * 2; return st * 1024 + (ob ^ (((ob >> 9) & 1) << 5)); }
__host__ __device__ __forceinline__ void stage_rc(int b, int& R, int& C) { const int st = b / 1024, sb = b % 1024, swz = sb ^ (((sb >> 9) & 1) << 5); R = (st >> 1) * 16 + swz / 64; C = (st & 1) * 32 + (swz % 64) / 2; }
__host__ __device__ __forceinline__ int perm32(int rho) { const int n = rho >> 4, i = rho & 15; return 8 * (i >> 2) + 4 * n + (i & 3); }

struct GUnit { const char* A; const char* B; int nt; int pm, pn, aux; };

__device__ __forceinline__ void tile_map(int L, int nM, int nN, int& tm, int& tn) {
    const int nwg = nM * nN; int wgid = L;
    { const int q = nwg / NXCD, r = nwg % NXCD, xcd = wgid % NXCD, off = wgid / NXCD; wgid = (xcd < r ? xcd * (q + 1) : r * (q + 1) + (xcd - r) * q) + off; }
    const int nig = WGM * nN, gid = wgid / nig, fm = gid * WGM, gsz = (nM - fm) < WGM ? (nM - fm) : WGM;
    tm = fm + ((wgid % nig) % gsz); tn = (wgid % nig) / gsz;
}

template <class Epi, class Sched>
__device__ __forceinline__ void gemm_phase(LAS unsigned char* lds, const int tid, const Sched S, const Epi E) {
    const int wid = __builtin_amdgcn_readfirstlane(tid >> 6), lane = tid & 63, wr = wid >> 2, wc = wid & 3, fr = lane & 15, fq = lane >> 4;
    unsigned voffA[2], voffB[2];
#pragma unroll
    for (int i = 0; i < 2; ++i) { int R, C; stage_rc(tid * 16 + i * 8192, R, C); const int Rb = Epi::PERM ? ((R & ~31) + perm32(R & 31)) : R;
        voffA[i] = (unsigned)(R * (int)S.lda + C) * 2u; voffB[i] = (unsigned)(Rb * (int)S.ldb + C) * 2u; }
    const size_t kstep = (size_t)(BK * 2);
    const size_t hstepA = (size_t)HALF * S.lda * 2, hstepB = (size_t)HALF * S.ldb * 2;
    const unsigned ldsm0 = (unsigned)__builtin_amdgcn_readfirstlane((int)((unsigned)(size_t)lds + (unsigned)wid * 1024u));
    const int aoff = lds_byte(wr * 64 + fr, fq * 8), boff = lds_byte(wc * 32 + fr, fq * 8);
#define PG8_SA(b, h) (((b) * 2 + (h)) * HTB)
#define PG8_SB(b, h) ((4 + (b) * 2 + (h)) * HTB)
#define PG8_STAGE(bufoff, gbase, voff) do { _Pragma("unroll") for (int _i = 0; _i < 2; ++_i) \
        asm volatile("s_mov_b32 m0, %0\n\tglobal_load_lds_dwordx4 %1, %2" :: "s"(ldsm0 + (unsigned)((bufoff) + _i * 8192)), "v"((voff)[_i]), "s"((const char*)(gbase)) : "memory"); } while (0)
#define PG8_LDA(dst, b, h) do { _Pragma("unroll") for (int m = 0; m < 4; ++m) _Pragma("unroll") for (int k = 0; k < 2; ++k) dst[m][k] = *(const LAS bf16x8*)(lds + PG8_SA(b, h) + aoff + m * 2048 + k * 1024); } while (0)
#define PG8_LDB(dst, b, h) do { _Pragma("unroll") for (int n = 0; n < 2; ++n) _Pragma("unroll") for (int k = 0; k < 2; ++k) dst[n][k] = *(const LAS bf16x8*)(lds + PG8_SB(b, h) + boff + n * 2048 + k * 1024); } while (0)
#define PG8_MMA(ai, bj, At, Bt) do { __builtin_amdgcn_s_setprio(1); _Pragma("unroll") for (int m = 0; m < 4; ++m) _Pragma("unroll") for (int n = 0; n < 2; ++n) _Pragma("unroll") for (int k = 0; k < 2; ++k) \
        acc[ai][bj][m][n] = __builtin_amdgcn_mfma_f32_16x16x32_bf16(Bt[n][k], At[m][k], acc[ai][bj][m][n], 0, 0, 0); __builtin_amdgcn_s_setprio(0); } while (0)
#define PG8_LDA8(dst, b, h) do { _Pragma("unroll") for (int m = 0; m < 4; ++m) { const i32x4 lo_ = *(const LAS i32x4*)(lds + PG8_SA(b, h) + aoff + m * 2048), hi_ = *(const LAS i32x4*)(lds + PG8_SA(b, h) + aoff + m * 2048 + 1024); \
        dst[m] = __builtin_shufflevector(lo_, hi_, 0, 1, 2, 3, 4, 5, 6, 7); } } while (0)
#define PG8_LDB8(dst, b, h) do { _Pragma("unroll") for (int n = 0; n < 2; ++n) { const i32x4 lo_ = *(const LAS i32x4*)(lds + PG8_SB(b, h) + boff + n * 2048), hi_ = *(const LAS i32x4*)(lds + PG8_SB(b, h) + boff + n * 2048 + 1024); \
        dst[n] = __builtin_shufflevector(lo_, hi_, 0, 1, 2, 3, 4, 5, 6, 7); } } while (0)
#define PG8_MMA8(ai, bj, At, Bt) do { __builtin_amdgcn_s_setprio(1); _Pragma("unroll") for (int m = 0; m < 4; ++m) _Pragma("unroll") for (int n = 0; n < 2; ++n) \
        asm volatile("v_mfma_f32_16x16x128_f8f6f4 %0, %1, %2, %0" : "+v"(acc[ai][bj][m][n]) : "v"(Bt[n]), "v"(At[m])); __builtin_amdgcn_s_setprio(0); } while (0)
#define PG8_MFMA_DRAIN asm volatile("s_nop 15\n\ts_nop 15" ::: "memory")
#define PG8_WAIT_V(n) asm volatile("s_waitcnt vmcnt(" #n ")" ::: "memory")
#define PG8_WAIT_L(n) asm volatile("s_waitcnt lgkmcnt(" #n ")" ::: "memory")
#define PG8_BAR __builtin_amdgcn_s_barrier()
#define PG8_SCHED __builtin_amdgcn_sched_barrier(0)
    GUnit cur, nxt; int ui = 0;
    if (!S.next(0, cur)) return;
    f32x4 acc[2][2][4][2];
#pragma unroll
    for (int a = 0; a < 2; ++a)
#pragma unroll
        for (int b = 0; b < 2; ++b)
#pragma unroll
            for (int m = 0; m < 4; ++m)
#pragma unroll
                for (int n = 0; n < 2; ++n) acc[a][b][m][n] = (f32x4){0.f, 0.f, 0.f, 0.f};
    bf16x8 At[4][2], B0[2][2], B1[2][2];
    u32x4 keep[8];
    const char* cA = cur.A; const char* cB = cur.B;
    f32x4 ssa, ssb;
    E.preload(cur, tid, ssa, ssb); E.finish(cur, tid, 0, ssa, ssb);
    PG8_STAGE(PG8_SB(0, 0), cB, voffB); PG8_STAGE(PG8_SB(0, 1), cB + hstepB, voffB); PG8_STAGE(PG8_SA(0, 0), cA, voffA); PG8_STAGE(PG8_SA(0, 1), cA + hstepA, voffA);
    if (wr == 1) PG8_BAR;
    PG8_WAIT_V(2); PG8_BAR;
    PG8_STAGE(PG8_SB(1, 0), cB + kstep, voffB); PG8_STAGE(PG8_SA(1, 0), cA + kstep, voffA); PG8_STAGE(PG8_SB(1, 1), cB + hstepB + kstep, voffB);
    PG8_WAIT_V(6); PG8_BAR;
    for (;;) {
        const bool has_next = S.next(ui + 1, nxt);
        const char* nA = has_next ? nxt.A : cA; const char* nB = has_next ? nxt.B : cB;
        const int nt = cur.nt;
#define PG8_KLOOP(LDA, LDB, MMA, At, B0, B1) \
        for (int t = 0; t < nt; t += 2) { \
            const bool last = (t == nt - 2); \
            const char* a1 = cA + (size_t)(t + 1) * kstep; \
            const char* a2 = last ? nA : cA + (size_t)(t + 2) * kstep; const char* b2 = last ? nB : cB + (size_t)(t + 2) * kstep; \
            const char* a3 = a2 + kstep; const char* b3 = b2 + kstep; \
            LDB(B0, 0, 0); LDB(B1, 0, 1); PG8_SCHED; LDA(At, 0, 0); PG8_STAGE(PG8_SA(1, 1), a1 + hstepA, voffA); \
            PG8_WAIT_V(8); PG8_WAIT_L(0); PG8_BAR; MMA(0, 0, At, B0); MMA(0, 1, At, B1); PG8_BAR; PG8_SCHED; \
            LDA(At, 0, 1); PG8_STAGE(PG8_SB(0, 0), b2, voffB); PG8_STAGE(PG8_SB(0, 1), b2 + hstepB, voffB); PG8_STAGE(PG8_SA(0, 0), a2, voffA); \
            PG8_WAIT_V(8); PG8_WAIT_L(0); PG8_BAR; MMA(1, 0, At, B0); MMA(1, 1, At, B1); PG8_BAR; PG8_SCHED; \
            LDB(B0, 1, 0); LDB(B1, 1, 1); PG8_SCHED; LDA(At, 1, 0); PG8_STAGE(PG8_SA(0, 1), a2 + hstepA, voffA); \
            PG8_WAIT_V(8); PG8_WAIT_L(0); PG8_BAR; MMA(0, 0, At, B0); MMA(0, 1, At, B1); PG8_BAR; PG8_SCHED; \
            LDA(At, 1, 1); PG8_STAGE(PG8_SB(1, 0), b3, voffB); PG8_STAGE(PG8_SB(1, 1), b3 + hstepB, voffB); PG8_STAGE(PG8_SA(1, 0), a3, voffA); \
            PG8_WAIT_V(8); PG8_WAIT_L(0); PG8_BAR; MMA(1, 0, At, B0); MMA(1, 1, At, B1); PG8_BAR; PG8_SCHED; \
        }
        if (Sched::F8 && (cur.aux & 1) == 0) { i32x8 A8[4], B80[2], B81[2]; PG8_KLOOP(PG8_LDA8, PG8_LDB8, PG8_MMA8, A8, B80, B81) PG8_MFMA_DRAIN; }
        else { PG8_KLOOP(PG8_LDA, PG8_LDB, PG8_MMA, At, B0, B1) }
#undef PG8_KLOOP
        if (wr == 0) PG8_BAR;
        { int fr_ = fr, fq_ = fq, tid_ = tid; asm volatile("" : "+v"(fr_), "+v"(fq_), "+v"(tid_));
          if (has_next) E.preload(nxt, tid_, ssa, ssb);
          E(acc, keep, cur, ui, tid_, wr, wc, fr_, fq_); }
        if (!has_next) break;
#pragma unroll
        for (int a = 0; a < 2; ++a)
#pragma unroll
            for (int b = 0; b < 2; ++b)
#pragma unroll
                for (int m = 0; m < 4; ++m)
#pragma unroll
                    for (int n = 0; n < 2; ++n) acc[a][b][m][n] = (f32x4){0.f, 0.f, 0.f, 0.f};
        cur = nxt; cA = nA; cB = nB; ++ui;
        E.finish(cur, tid, ui, ssa, ssb);
        if (wr == 1) PG8_BAR;
    }
    PG8_WAIT_V(0);
    PG8_BAR;
#undef PG8_SA
#undef PG8_SB
#undef PG8_STAGE
#undef PG8_LDA
#undef PG8_LDB
#undef PG8_MMA
#undef PG8_LDA8
#undef PG8_LDB8
#undef PG8_MMA8
#undef PG8_MFMA_DRAIN
#undef PG8_WAIT_V
#undef PG8_WAIT_L
#undef PG8_BAR
#undef PG8_SCHED
}

struct SchedStd {
    static constexpr bool F8 = false;
    int nM, nN, G, c, nt; unsigned lda, ldb; const char* A; const char* B; size_t bBatch;
    __device__ __forceinline__ bool next(int i, GUnit& u) const {
        const long L = (long)i * G + c; if (L >= (long)nM * nN) return false;
        int tm, tn; tile_map((int)L, nM, nN, tm, tn);
        u.A = A + (size_t)tm * 256 * lda * 2; u.B = B + (size_t)tn * 256 * ldb * 2 + ((bBatch && tm >= nM / 2) ? bBatch : 0);
        u.nt = nt; u.pm = tm * 256; u.pn = tn * 256; u.aux = 0; return true;
    }
};
struct SchedStd8 {
    static constexpr bool F8 = true;
    int nM, nN, G, c, nt; unsigned lda, ldb; const char* A; const char* B; size_t bBatch;
    __device__ __forceinline__ bool next(int i, GUnit& u) const {
        const long L = (long)i * G + c; if (L >= (long)nM * nN) return false;
        int tm, tn; tile_map((int)L, nM, nN, tm, tn);
        u.A = A + (size_t)tm * 256 * lda * 2; u.B = B + (size_t)tn * 256 * ldb * 2 + ((bBatch && tm >= nM / 2) ? bBatch : 0);
        u.nt = nt; u.pm = tm * 256; u.pn = tn * 256; u.aux = 0; return true;
    }
};
struct SchedMerge {
    static constexpr bool F8 = true;
    int G, c; unsigned lda, ldb; const char* H; const char* O; const char* WG; const char* WB;
    __device__ __forceinline__ bool next(int i, GUnit& u) const {
        const long T = (long)(i >> 3) * G + c; if (T >= 128 * 8) return false;
        const int sub = i & 7, b = sub >> 1, kind = sub & 1;
        int tm, tn; tile_map((int)T, 128, 8, tm, tn);
        if (kind == 0) { u.A = H + (size_t)tm * 256 * 2048 * 2; u.B = WG + ((size_t)b * 2048 + tn * 256) * 2048 * 2; u.nt = 16; }
        else           { u.A = O + (size_t)tm * 256 * 2048 * 2 + b * 512 * 2; u.B = WB + (size_t)tn * 256 * 2048 * 2 + b * 512 * 2; u.nt = 8; }
        u.pm = tm * 256; u.pn = tn * 256; u.aux = sub; return true;
    }
};
struct SchedKV {
    static constexpr bool F8 = false;
    int G, c; unsigned lda, ldb; const char* A; const char* B;
    __device__ __forceinline__ bool next(int i, GUnit& u) const {
        const int L = i * G + c; if (L >= 128) return false;
        const int tm = L & 1, tn = (L >> 1) & 15, l = L >> 5;
        u.A = A + (size_t)tm * (256u * 2048 * 2); u.B = B + (size_t)l * (4096u * 2048 * 2) + (size_t)tn * (256u * 2048 * 2);
        u.pm = l * 512 + tm * 256; u.pn = tn * 256; u.nt = 32; u.aux = 0; return true;
    }
};
struct SchedWQK {
    static constexpr bool F8 = false;
    int G, c; unsigned lda, ldb; const char* A; const char* B;
    __device__ __forceinline__ bool next(int i, GUnit& u) const {
        const int L = i * G + c; if (L >= 256) return false;
        const int tn = L & 7, h = (L >> 3) & 3, b = (L >> 5) & 1, l = L >> 6;
        u.A = A + (size_t)l * (512u * 4096 * 2) + (size_t)b * (256u * 4096 * 2) + h * 1024;
        u.B = B + (size_t)l * (2048u * 2048 * 2) + (size_t)tn * (256u * 2048 * 2) + h * 1024;
        u.pm = l * 2048 + b * 1024 + h * 256; u.pn = tn * 256; u.nt = 8; u.aux = 0; return true;
    }
};
struct SchedVWO {
    static constexpr bool F8 = false;
    int G, c; unsigned lda, ldb; const char* A; const char* B;
    __device__ __forceinline__ bool next(int i, GUnit& u) const {
        const int L = i * G + c; if (L >= 256) return false;
        const int tm = L & 7, h = (L >> 3) & 3, b = (L >> 5) & 1, l = L >> 6;
        u.A = A + (size_t)l * (2048u * 2048 * 2) + (size_t)tm * (256u * 2048 * 2) + h * 1024;
        u.B = B + (size_t)l * (512u * 4096 * 2) + (size_t)b * (256u * 4096 * 2) + 4096 + h * 1024;
        u.pm = l * 4096 + b * 2048 + tm * 256; u.pn = h * 256; u.nt = 8; u.aux = 0; return true;
    }
};
struct SchedCmpOne {
    static constexpr bool F8 = false;
    int L; unsigned lda, ldb; const char* A; const char* B;
    __device__ __forceinline__ bool next(int i, GUnit& u) const {
        if (i != 0) return false;
        const int tm = L & 7, kv = L >> 3;
        u.A = A + (size_t)kv * CKV_BYTES + (size_t)tm * (256u * 2048 * 2); u.B = B + (size_t)kv * (256u * 4096 * 2);
        u.pm = kv * 2048 + tm * 256; u.pn = 0; u.nt = 64; u.aux = kv; return true;
    }
};
struct SchedCmp {
    static constexpr bool F8 = false;
    int G, c; unsigned lda, ldb; const char* A; const char* B;
    __device__ __forceinline__ bool next(int i, GUnit& u) const {
        const int L = i * G + c; if (L >= 16) return false;
        const int tm = L & 7, kv = L >> 3;
        u.A = A + (size_t)kv * CKV_BYTES + (size_t)tm * (256u * 2048 * 2); u.B = B + (size_t)kv * (256u * 4096 * 2);
        u.pm = kv * 2048 + tm * 256; u.pn = 0; u.nt = 64; u.aux = kv; return true;
    }
};

#define EPI_ARGS const f32x4 (&acc)[2][2][4][2], u32x4 (&keep)[8], const GUnit& u, int ui, int tid, int wr, int wc, int fr, int fq
#define EPI_NOBEGIN __device__ __forceinline__ void preload(const GUnit&, int, f32x4&, f32x4&) const {} __device__ __forceinline__ void finish(const GUnit&, int, int, const f32x4&, const f32x4&) const {}
constexpr int RSBUF_OFF = 131072 + 4096;
__device__ __forceinline__ void rs_preload(const float* SS, const GUnit& u, int tid, f32x4& a, f32x4& b) {
    if (tid < 256) { const float* sp = SS + (size_t)(u.pm + tid) * 8; a = *(const f32x4*)sp; b = *(const f32x4*)(sp + 4); }
}
__device__ __forceinline__ void rs_finish(LAS unsigned char* lds, int tid, int ui, const f32x4& a, const f32x4& b) {
    if (tid < 256) ((LAS float*)(lds + RSBUF_OFF))[(ui & 1) * 256 + tid] = rsqrtf((((a[0] + a[1]) + (a[2] + a[3])) + ((b[0] + b[1]) + (b[2] + b[3]))) * (1.f / 2048.f) + 1e-6f);
}
__device__ __forceinline__ void rs_get(LAS unsigned char* lds, int ui, int wr, int fr, float (&rs)[2][4]) {
#pragma unroll
    for (int ai = 0; ai < 2; ++ai)
#pragma unroll
        for (int m = 0; m < 4; ++m) rs[ai][m] = ((const LAS float*)(lds + RSBUF_OFF))[(ui & 1) * 256 + ai * HALF + wr * 64 + m * 16 + fr];
}
struct EpiGen {
    static constexpr bool PERM = true;
    bf16_t* O; const float* bias; int ldc, mode; float scale; int pad_;
    EPI_NOBEGIN
    __device__ __forceinline__ void operator()(EPI_ARGS) const {
        const int row0 = u.pm + wr * 64 + fr, colt = wc * 32 + 8 * fq;
#pragma unroll
        for (int bj = 0; bj < 2; ++bj) {
            f32x4 bv0 = (f32x4){0.f, 0.f, 0.f, 0.f}, bv1 = bv0;
            if (mode == 1) { const float* bp = bias + u.aux * 256 + colt + bj * HALF; bv0 = *(const f32x4*)bp; bv1 = *(const f32x4*)(bp + 4); }
#pragma unroll
            for (int ai = 0; ai < 2; ++ai)
#pragma unroll
                for (int m = 0; m < 4; ++m) {
                    f32x4 v0 = acc[ai][bj][m][0] * scale + bv0, v1 = acc[ai][bj][m][1] * scale + bv1;
                    if (mode == 1) {
#pragma unroll
                        for (int e = 0; e < 4; ++e) { v0[e] = siluf_(v0[e]); v1[e] = siluf_(v1[e]); }
                    }
                    if (mode == 2) {
                        *(u32x2*)((unsigned char*)O + (size_t)(row0 + ai * HALF + m * 16) * ldc + u.pn + colt + bj * HALF) = (u32x2){cvt4_fp8(v0[0], v0[1], v0[2], v0[3]), cvt4_fp8(v1[0], v1[1], v1[2], v1[3])};
                    } else {
                    bf16_t* p = O + (size_t)(row0 + ai * HALF + m * 16) * ldc + u.pn + colt + bj * HALF;
                    *(u32x4*)p = (u32x4){cvtpk(v0[0], v0[1]), cvtpk(v0[2], v0[3]), cvtpk(v1[0], v1[1]), cvtpk(v1[2], v1[3])}; }
                }
        }
    }
};
struct EpiInProj {
    static constexpr bool PERM = true;
    bf16_t* P; bf16_t* CK; bf16_t* CV; const float* SS; LAS unsigned char* lds;
    __device__ __forceinline__ void preload(const GUnit& u, int tid, f32x4& a, f32x4& b) const { rs_preload(SS, u, tid, a, b); }
    __device__ __forceinline__ void finish(const GUnit&, int tid, int ui, const f32x4& a, const f32x4& b) const { rs_finish(lds, tid, ui, a, b); }
    __device__ __forceinline__ void operator()(EPI_ARGS) const {
        const int row0 = u.pm + wr * 64 + fr, colt = wc * 32 + 8 * fq;
        const bool ckv = (u.pn == C_KC);
        float rs[2][4]; rs_get(lds, ui, wr, fr, rs);
#pragma unroll
        for (int bj = 0; bj < 2; ++bj) {
            bf16_t* base; size_t ld;
            if (ckv) { base = (bj ? CV : CK) + colt; ld = 128; } else { base = P + u.pn + colt + bj * HALF; ld = NP; }
#pragma unroll
            for (int ai = 0; ai < 2; ++ai)
#pragma unroll
                for (int m = 0; m < 4; ++m) {
                    const f32x4 v0 = acc[ai][bj][m][0] * rs[ai][m], v1 = acc[ai][bj][m][1] * rs[ai][m];
                    *(u32x4*)(base + (size_t)(row0 + ai * HALF + m * 16) * ld) = (u32x4){cvtpk(v0[0], v0[1]), cvtpk(v0[2], v0[3]), cvtpk(v1[0], v1[1]), cvtpk(v1[2], v1[3])};
                }
        }
    }
};
struct EpiFfn1 {
    static constexpr bool PERM = true;
    bf16_t* Hd; const float* SS; LAS unsigned char* lds;
    __device__ __forceinline__ void preload(const GUnit& u, int tid, f32x4& a, f32x4& b) const { rs_preload(SS, u, tid, a, b); }
    __device__ __forceinline__ void finish(const GUnit&, int tid, int ui, const f32x4& a, const f32x4& b) const { rs_finish(lds, tid, ui, a, b); }
    __device__ __forceinline__ void operator()(EPI_ARGS) const {
        const int row0 = u.pm + wr * 64 + fr, col0 = (u.pn >> 1) + wc * 32 + 8 * fq;
        float rs[2][4]; rs_get(lds, ui, wr, fr, rs);
#pragma unroll
        for (int ai = 0; ai < 2; ++ai)
#pragma unroll
            for (int m = 0; m < 4; ++m) {
                float r[8];
#pragma unroll
                for (int n = 0; n < 2; ++n)
#pragma unroll
                    for (int e = 0; e < 4; ++e) r[n * 4 + e] = siluf_(acc[ai][0][m][n][e] * rs[ai][m]) * (acc[ai][1][m][n][e] * rs[ai][m]);
                *(u32x4*)(Hd + (size_t)(row0 + ai * HALF + m * 16) * DFF + col0) = (u32x4){cvtpk(r[0], r[1]), cvtpk(r[2], r[3]), cvtpk(r[4], r[5]), cvtpk(r[6], r[7])};
            }
    }
};
struct EpiResid {
    static constexpr bool PERM = true;
    bf16_t* XH; float* SS; LAS float* red; unsigned char* X8; float sc; int pad_;
    EPI_NOBEGIN
    __device__ __forceinline__ void operator()(EPI_ARGS) const {
        const int row0 = u.pm + wr * 64 + fr, col0 = u.pn + wc * 32 + 8 * fq;
        u32x4 xh[2][4][2];
#pragma unroll
        for (int ai = 0; ai < 2; ++ai)
#pragma unroll
            for (int m = 0; m < 4; ++m)
#pragma unroll
                for (int bj = 0; bj < 2; ++bj) xh[ai][m][bj] = *(const u32x4*)(XH + (size_t)(row0 + ai * HALF + m * 16) * DM + col0 + bj * HALF);
#pragma unroll
        for (int ai = 0; ai < 2; ++ai)
#pragma unroll
            for (int m = 0; m < 4; ++m) { const size_t ro = (size_t)(row0 + ai * HALF + m * 16) * DM + col0; float ss = 0.f;
#pragma unroll
                for (int bj = 0; bj < 2; ++bj) { const size_t o = ro + bj * HALF; float v[8]; unsigned hw[4]; const u32x4 ph = xh[ai][m][bj];
#pragma unroll
                    for (int j = 0; j < 4; ++j) { v[2 * j] = bflo(ph[j]) + acc[ai][bj][m][j >> 1][(2 * j) & 3] * sc; v[2 * j + 1] = bfhi(ph[j]) + acc[ai][bj][m][j >> 1][(2 * j + 1) & 3] * sc; }
#pragma unroll
                    for (int j = 0; j < 4; ++j) { hw[j] = cvtpk(v[2 * j], v[2 * j + 1]); const float r0 = bflo(hw[j]), r1 = bfhi(hw[j]); ss += r0 * r0 + r1 * r1; }
                    *(u32x4*)(XH + o) = (u32x4){hw[0], hw[1], hw[2], hw[3]};
                    if (X8) *(u32x2*)(X8 + (size_t)(row0 + ai * HALF + m * 16) * 4096 + col0 + bj * HALF) = (u32x2){cvt4_fp8(v[0], v[1], v[2], v[3]), cvt4_fp8(v[4], v[5], v[6], v[7])}; }
                ss += __shfl_xor(ss, 16); ss += __shfl_xor(ss, 32);
                if (fq == 0) red[wc * 256 + ai * HALF + wr * 64 + m * 16 + fr] = ss; }
        asm volatile("s_waitcnt lgkmcnt(0)" ::: "memory"); __builtin_amdgcn_s_barrier();
        if (tid < 256) SS[(size_t)(u.pm + tid) * 8 + (u.pn >> 8)] = (red[tid] + red[256 + tid]) + (red[512 + tid] + red[768 + tid]);
        asm volatile("s_waitcnt lgkmcnt(0)" ::: "memory"); __builtin_amdgcn_s_barrier();
    }
};
struct EpiF32 {
    static constexpr bool PERM = false;
    float* C; const float* SS; LAS unsigned char* lds; int ldc, pad_;
    __device__ __forceinline__ void preload(const GUnit& u, int tid, f32x4& a, f32x4& b) const { rs_preload(SS, u, tid, a, b); }
    __device__ __forceinline__ void finish(const GUnit&, int tid, int ui, const f32x4& a, const f32x4& b) const { rs_finish(lds, tid, ui, a, b); }
    __device__ __forceinline__ void operator()(EPI_ARGS) const {
        const int row0 = u.pm + wr * 64 + fr, col0 = u.pn + wc * 32 + 4 * fq;
        float rs[2][4]; rs_get(lds, ui, wr, fr, rs);
#pragma unroll
        for (int ai = 0; ai < 2; ++ai)
#pragma unroll
            for (int m = 0; m < 4; ++m) { float* rp = C + (size_t)(row0 + ai * HALF + m * 16) * ldc + col0;
#pragma unroll
                for (int bj = 0; bj < 2; ++bj)
#pragma unroll
                    for (int n = 0; n < 2; ++n) *(f32x4*)(rp + bj * HALF + n * 16) = acc[ai][bj][m][n] * rs[ai][m]; }
    }
};
struct EpiXaSoftmax {
    static constexpr bool PERM = true;
    bf16_t* Pq; const float* SS; LAS unsigned char* lds;
    __device__ __forceinline__ void preload(const GUnit& u, int tid, f32x4& a, f32x4& b) const { rs_preload(SS, u, tid, a, b); }
    __device__ __forceinline__ void finish(const GUnit&, int tid, int ui, const f32x4& a, const f32x4& b) const { rs_finish(lds, tid, ui, a, b); }
    __device__ __forceinline__ void operator()(EPI_ARGS) const {
        LAS float* redm = (LAS float*)(lds + 131072); LAS float* reds = (LAS float*)(lds + 131072 + 8192);
        const int row0 = u.pm + wr * 64 + fr, col0 = u.pn + wc * 32 + 8 * fq;
        float rs[2][4]; rs_get(lds, ui, wr, fr, rs);
#pragma unroll
        for (int ai = 0; ai < 2; ++ai)
#pragma unroll
            for (int m = 0; m < 4; ++m) rs[ai][m] *= (1.f / GATE_WSCALE);
        float mx[2][4];
#pragma unroll
        for (int ai = 0; ai < 2; ++ai)
#pragma unroll
            for (int m = 0; m < 4; ++m) { float v = -3.0e38f;
#pragma unroll
                for (int bj = 0; bj < 2; ++bj)
#pragma unroll
                    for (int n = 0; n < 2; ++n)
#pragma unroll
                        for (int e = 0; e < 4; ++e) v = fmaxf(v, acc[ai][bj][m][n][e]);
                v = fmaxf(v, __shfl_xor(v, 16)); v = fmaxf(v, __shfl_xor(v, 32));
                if (fq == 0) redm[wc * 256 + ai * HALF + wr * 64 + m * 16 + fr] = v; }
        asm volatile("s_waitcnt lgkmcnt(0)" ::: "memory"); __builtin_amdgcn_s_barrier();
        float ex[2][4][2][2][4];
#pragma unroll
        for (int ai = 0; ai < 2; ++ai)
#pragma unroll
            for (int m = 0; m < 4; ++m) { const int rl = ai * HALF + wr * 64 + m * 16 + fr;
                const float mm = fmaxf(fmaxf(redm[rl], redm[256 + rl]), fmaxf(redm[512 + rl], redm[768 + rl])) * rs[ai][m];
                mx[ai][m] = mm; float sum = 0.f;
#pragma unroll
                for (int bj = 0; bj < 2; ++bj)
#pragma unroll
                    for (int n = 0; n < 2; ++n)
#pragma unroll
                        for (int e = 0; e < 4; ++e) { const float x = __expf(acc[ai][bj][m][n][e] * rs[ai][m] - mm); ex[ai][m][bj][n][e] = x; sum += x; }
                sum += __shfl_xor(sum, 16); sum += __shfl_xor(sum, 32);
                if (fq == 0) reds[wc * 256 + rl] = sum; }
        asm volatile("s_waitcnt lgkmcnt(0)" ::: "memory"); __builtin_amdgcn_s_barrier();
#pragma unroll
        for (int ai = 0; ai < 2; ++ai)
#pragma unroll
            for (int m = 0; m < 4; ++m) { const int rl = ai * HALF + wr * 64 + m * 16 + fr;
                const float inv = XA_PSCALE / ((reds[rl] + reds[256 + rl]) + (reds[512 + rl] + reds[768 + rl]));
#pragma unroll
                for (int bj = 0; bj < 2; ++bj) { const float* x = &ex[ai][m][bj][0][0];
                    *(u32x2*)((unsigned char*)Pq + (size_t)(row0 + ai * HALF + m * 16) * 1024 + col0 + bj * HALF) =
                        (u32x2){cvt4_fp8(x[0] * inv, x[1] * inv, x[2] * inv, x[3] * inv), cvt4_fp8(x[4] * inv, x[5] * inv, x[6] * inv, x[7] * inv)}; } }
        (void)mx;
        asm volatile("s_waitcnt lgkmcnt(0)" ::: "memory"); __builtin_amdgcn_s_barrier();
    }
};
struct EpiMerge {
    static constexpr bool PERM = true;
    bf16_t* gs; bf16_t* ma; bf16_t* MG; const float* SS; LAS unsigned char* lds;
    __device__ __forceinline__ void preload(const GUnit&, int, f32x4&, f32x4&) const {}
    __device__ __forceinline__ void finish(const GUnit& u, int tid, int ui, const f32x4&, const f32x4&) const {
        if (u.aux == 0) { f32x4 a = (f32x4){0.f, 0.f, 0.f, 0.f}, b = a; rs_preload(SS, u, tid, a, b); rs_finish(lds, tid, ui >> 3, a, b); } }
    __device__ __forceinline__ void operator()(EPI_ARGS) const {
        const int sub = u.aux, b = sub >> 1;
        const int row0 = u.pm + wr * 64 + fr, col0 = u.pn + wc * 32 + 8 * fq;
        if ((sub & 1) == 0) {
            float rs[2][4]; rs_get(lds, ui >> 3, wr, fr, rs);
#pragma unroll
            for (int ai = 0; ai < 2; ++ai)
#pragma unroll
                for (int m = 0; m < 4; ++m) rs[ai][m] *= (1.f / GATE_WSCALE);
#pragma unroll
            for (int ai = 0; ai < 2; ++ai)
#pragma unroll
                for (int m = 0; m < 4; ++m)
#pragma unroll
                    for (int bj = 0; bj < 2; ++bj) {
                        const int slot = ((ai * 4 + m) * 2 + bj);
                        const f32x4 v0 = acc[ai][bj][m][0] * rs[ai][m], v1 = acc[ai][bj][m][1] * rs[ai][m];
                        const u32x4 lg = (u32x4){cvtpk(v0[0], v0[1]), cvtpk(v0[2], v0[3]), cvtpk(v1[0], v1[1]), cvtpk(v1[2], v1[3])};
                        if (slot < 6) keep[slot] = lg;
                        else *(u32x4*)(gs + ((size_t)slot * NTHREADS + tid) * 8) = lg;
                    }
        } else {
#pragma unroll
            for (int bt = 0; bt < 2; ++bt) {
                u32x4 g[8], pm[8];
#pragma unroll
                for (int j = 0; j < 8; ++j) { const int slot = bt * 8 + j; {
                        g[j] = (slot < 6) ? keep[slot & 7] : *(const u32x4*)(gs + ((size_t)slot * NTHREADS + tid) * 8);
                        pm[j] = (b > 0) ? *(const u32x4*)(ma + ((size_t)slot * NTHREADS + tid) * 8) : (u32x4){0u, 0u, 0u, 0u}; } }
#pragma unroll
                for (int j = 0; j < 8; ++j) { const int slot = bt * 8 + j; { const int ai = slot >> 3, m = (slot >> 1) & 3, bj = slot & 1;
                        const f32x4 v0 = acc[ai][bj][m][0], v1 = acc[ai][bj][m][1]; const u32x4 gg = g[j], pp = pm[j];
                        const f32x4 r0 = (f32x4){sigmoidf_(bflo(gg[0])) * v0[0] + bflo(pp[0]), sigmoidf_(bfhi(gg[0])) * v0[1] + bfhi(pp[0]), sigmoidf_(bflo(gg[1])) * v0[2] + bflo(pp[1]), sigmoidf_(bfhi(gg[1])) * v0[3] + bfhi(pp[1])};
                        const f32x4 r1 = (f32x4){sigmoidf_(bflo(gg[2])) * v1[0] + bflo(pp[2]), sigmoidf_(bfhi(gg[2])) * v1[1] + bfhi(pp[2]), sigmoidf_(bflo(gg[3])) * v1[2] + bflo(pp[3]), sigmoidf_(bfhi(gg[3])) * v1[3] + bfhi(pp[3])};
                        const u32x4 outw = (u32x4){cvtpk(r0[0], r0[1]), cvtpk(r0[2], r0[3]), cvtpk(r1[0], r1[1]), cvtpk(r1[2], r1[3])};
                        if (b < 3) *(u32x4*)(ma + ((size_t)slot * NTHREADS + tid) * 8) = outw;
                        else *(u32x4*)(MG + (size_t)(row0 + ai * HALF + m * 16) * DM + col0 + bj * HALF) = outw; } }
                asm volatile("" ::: "memory"); __builtin_amdgcn_sched_barrier(0);
            }
        }
    }
};
#undef EPI_ARGS
}
template <int MAP> __device__ __forceinline__ int cmap(int n) {
    if (MAP == 0) return n;
    if (MAP == 1) return n < C_GZ ? n : (n < C_NG ? n + 12 : (n < C_NG + 12 ? n - 1024 : -1));
    if (MAP == 2) return 5900 + n;
    return ((n & 255) < 128) ? ((n >> 8) * 128 + (n & 127)) : (DFF + (n >> 8) * 128 + (n & 127));
}
template <int MAP, bool F8 = false>
__device__ __forceinline__ void convert_T(const Frame& F, const float* src, int src_ld, int K, bf16_t* dst, int dst_ld, int NN, const float* kscale) {
    LAS float* tile = (LAS float*)F.lds;
    const int tk = K / 64, tn = NN / 128, total = tk * tn;
    const int lk = F.tid >> 5, ln = (F.tid & 31) * 4;
    f32x4 cur[4], nxt[4];
#define CVT_LOAD(dstv, t_) do { const int n0_ = ((t_) / tk) * 128, k0_ = ((t_) % tk) * 64; const int col_ = cmap<MAP>(n0_ + ln); \
        _Pragma("unroll") for (int i = 0; i < 4; ++i) { const int kk_ = k0_ + lk + 16 * i; \
            dstv[i] = (col_ >= 0) ? *(const f32x4*)(src + (size_t)kk_ * src_ld + col_) * (kscale ? kscale[kk_] : 1.f) : (f32x4){0.f, 0.f, 0.f, 0.f}; } } while (0)
    int t = F.wg;
    if (t < total) CVT_LOAD(cur, t);
    for (; t < total; t += F.G) {
        const int tn_ = t + F.G;
        if (tn_ < total) CVT_LOAD(nxt, tn_);
#pragma unroll
        for (int i = 0; i < 4; ++i) { LAS float* tp = tile + (lk + 16 * i) * 129 + ln; tp[0] = cur[i][0]; tp[1] = cur[i][1]; tp[2] = cur[i][2]; tp[3] = cur[i][3]; }
        __syncthreads();
        { const int n0 = (t / tk) * 128, k0 = (t % tk) * 64; const int r = F.tid >> 2, cseg = (F.tid & 3) * 16; float v[16];
#pragma unroll
          for (int j = 0; j < 16; ++j) v[j] = tile[(cseg + j) * 129 + r];
          bf16_t* dp = dst + (size_t)(n0 + r) * dst_ld + k0 + cseg;
          if (F8) {
              *(u32x4*)((unsigned char*)dst + (size_t)(n0 + r) * dst_ld * 2 + k0 + cseg) = (u32x4){cvt4_fp8(v[0] * GATE_WSCALE, v[1] * GATE_WSCALE, v[2] * GATE_WSCALE, v[3] * GATE_WSCALE),
                  cvt4_fp8(v[4] * GATE_WSCALE, v[5] * GATE_WSCALE, v[6] * GATE_WSCALE, v[7] * GATE_WSCALE), cvt4_fp8(v[8] * GATE_WSCALE, v[9] * GATE_WSCALE, v[10] * GATE_WSCALE, v[11] * GATE_WSCALE),
                  cvt4_fp8(v[12] * GATE_WSCALE, v[13] * GATE_WSCALE, v[14] * GATE_WSCALE, v[15] * GATE_WSCALE)};
          } else {
          *(u32x4*)dp = (u32x4){cvtpk(v[0], v[1]), cvtpk(v[2], v[3]), cvtpk(v[4], v[5]), cvtpk(v[6], v[7])};
          *(u32x4*)(dp + 8) = (u32x4){cvtpk(v[8], v[9]), cvtpk(v[10], v[11]), cvtpk(v[12], v[13]), cvtpk(v[14], v[15])}; } }
        __syncthreads();
#pragma unroll
        for (int i = 0; i < 4; ++i) cur[i] = nxt[i];
    }
#undef CVT_LOAD
}
__device__ __forceinline__ void convert_plain(const Frame& F, const float* src, bf16_t* dst, size_t n) {
    for (size_t i = ((size_t)F.wg * NTHREADS + F.tid) * 8; i < n; i += (size_t)F.G * NTHREADS * 8) {
        const f32x4 a = *(const f32x4*)(src + i), b = *(const f32x4*)(src + i + 4);
        *(u32x4*)(dst + i) = (u32x4){cvtpk(a[0], a[1]), cvtpk(a[2], a[3]), cvtpk(b[0], b[1]), cvtpk(b[2], b[3])};
    }
}
template <bool OUTF32>
__device__ __forceinline__ void rmsnorm_rows(const Frame& F, const float* x, const float* w, bf16_t* dstb, float* dstf, int rows) {
    for (int r = F.wg * 8 + F.wave; r < rows; r += F.G * 8) {
        const float* xp = x + (size_t)r * DM; f32x4 v[8]; float ss = 0.f;
#pragma unroll
        for (int i = 0; i < 8; ++i) { v[i] = *(const f32x4*)(xp + i * 256 + F.lane * 4); ss += v[i][0] * v[i][0] + v[i][1] * v[i][1] + v[i][2] * v[i][2] + v[i][3] * v[i][3]; }
        ss = wave_sum(ss);
        const float rs = rsqrtf(ss * (1.f / DM) + 1e-6f);
#pragma unroll
        for (int i = 0; i < 8; ++i) { const f32x4 g = *(const f32x4*)(w + i * 256 + F.lane * 4); const f32x4 y = v[i] * rs * g;
            if (OUTF32) *(f32x4*)(dstf + (size_t)r * DM + i * 256 + F.lane * 4) = y;
            else *(u32x2*)(dstb + (size_t)r * DM + i * 256 + F.lane * 4) = (u32x2){cvtpk(y[0], y[1]), cvtpk(y[2], y[3])}; }
    }
}

__device__ __forceinline__ void final_norm(const Frame& F, float* out, const float* w, const float* SS) {
    const bf16_t* XH = (const bf16_t*)(F.ws + WS_H);
    for (int r = F.wg * 8 + F.wave; r < MT; r += F.G * 8) {
        const float* sp = SS + (size_t)r * 8; const f32x4 a = *(const f32x4*)sp, b = *(const f32x4*)(sp + 4);
        const float rs = rsqrtf((((a[0] + a[1]) + (a[2] + a[3])) + ((b[0] + b[1]) + (b[2] + b[3]))) * (1.f / 2048.f) + 1e-6f);
#pragma unroll
        for (int i = 0; i < 4; ++i) { const size_t o = (size_t)r * DM + i * 512 + F.lane * 8;
            const u32x4 h = *(const u32x4*)(XH + o); const f32x4 w0 = *(const f32x4*)(w + i * 512 + F.lane * 8), w1 = *(const f32x4*)(w + i * 512 + F.lane * 8 + 4);
            *(f32x4*)(out + o) = (f32x4){bflo(h[0]) * rs * w0[0], bfhi(h[0]) * rs * w0[1], bflo(h[1]) * rs * w0[2], bfhi(h[1]) * rs * w0[3]};
            *(f32x4*)(out + o + 4) = (f32x4){bflo(h[2]) * rs * w1[0], bfhi(h[2]) * rs * w1[1], bflo(h[3]) * rs * w1[2], bfhi(h[3]) * rs * w1[3]}; }
    }
}

__device__ __forceinline__ void p0_prologue(const Frame& F) {
    unsigned char* ws = F.ws;
    for (int l = 0; l < DEPTH; ++l) {
        convert_T<1>(F, F.inp(4) + (size_t)l * DM * NIN, NIN, DM, (bf16_t*)(ws + WS_WIN) + (size_t)l * NP * DM, DM, NP, F.inp(3) + l * DM);
        convert_T<2, true>(F, F.inp(4) + (size_t)l * DM * NIN, NIN, DM, (bf16_t*)(ws + WS_WG) + (size_t)l * 8192 * DM, DM, 8192, F.inp(3) + l * DM);
        for (int b = 0; b < 4; ++b)
            convert_T<0>(F, F.inp(22) + ((size_t)l * 4 + b) * 512 * DM, DM, 512, (bf16_t*)(ws + WS_WB) + (size_t)l * DM * DM + b * 512, DM, DM, nullptr);
        convert_T<0>(F, F.inp(23) + (size_t)l * DM * DM, DM, DM, (bf16_t*)(ws + WS_WO) + (size_t)l * DM * DM, DM, DM, nullptr);
        convert_T<3>(F, F.inp(29) + (size_t)l * DM * 2 * DFF, 2 * DFF, DM, (bf16_t*)(ws + WS_FF1) + (size_t)l * 2 * DFF * DM, DM, 2 * DFF, F.inp(28) + l * DM);
        convert_T<0>(F, F.inp(30) + (size_t)l * DFF * DM, DM, DFF, (bf16_t*)(ws + WS_FF2) + (size_t)l * DM * DFF, DFF, DM, nullptr);
        convert_T<0>(F, F.inp(13) + (size_t)l * 4096 * 256, 256, 4096, (bf16_t*)(ws + WS_CW1) + ((size_t)l * 2 + 0) * 256 * 4096, 4096, 256, nullptr);
        convert_T<0>(F, F.inp(16) + (size_t)l * 4096 * 256, 256, 4096, (bf16_t*)(ws + WS_CW1) + ((size_t)l * 2 + 1) * 256 * 4096, 4096, 256, nullptr);
        convert_T<0>(F, F.inp(14) + (size_t)l * 256 * 128, 128, 256, (bf16_t*)(ws + WS_CW2) + ((size_t)l * 2 + 0) * 128 * 256, 256, 128, nullptr);
        convert_T<0>(F, F.inp(17) + (size_t)l * 256 * 128, 128, 256, (bf16_t*)(ws + WS_CW2) + ((size_t)l * 2 + 1) * 128 * 256, 256, 128, nullptr);
        convert_T<0>(F, F.inp(26) + (size_t)l * DM * 2 * DM, 2 * DM, DM, (bf16_t*)(ws + WS_WKVT) + (size_t)l * 2 * DM * DM, DM, 2 * DM, nullptr);
        convert_T<0>(F, F.inp(27) + (size_t)l * DM * DM, DM, DM, (bf16_t*)(ws + WS_WOT) + (size_t)l * DM * DM, DM, DM, nullptr);
    }
    for (size_t i = ((size_t)F.wg * NTHREADS + F.tid) * 8; i < (size_t)DEPTH * DM * DM; i += (size_t)F.G * NTHREADS * 8) {
        const float g = F.inp(24)[i >> 11];
        const f32x4 a = *(const f32x4*)(F.inp(25) + i) * g, b = *(const f32x4*)(F.inp(25) + i + 4) * g;
        *(u32x4*)((bf16_t*)(ws + WS_WQB) + i) = (u32x4){cvtpk(a[0], a[1]), cvtpk(a[2], a[3]), cvtpk(b[0], b[1]), cvtpk(b[2], b[3])};
    }
    for (int r = F.wg * 8 + F.wave; r < MT; r += F.G * 8) {
        const float* xp = F.inp(0) + (size_t)r * DM; float ss = 0.f;
#pragma unroll
        for (int i = 0; i < 8; ++i) { const f32x4 v = *(const f32x4*)(xp + i * 256 + F.lane * 4);
            const unsigned h0 = cvtpk(v[0], v[1]), h1 = cvtpk(v[2], v[3]);
            ss += bflo(h0) * bflo(h0) + bfhi(h0) * bfhi(h0) + bflo(h1) * bflo(h1) + bfhi(h1) * bfhi(h1);
            *(u32x2*)((bf16_t*)(ws + WS_H) + (size_t)r * DM + i * 256 + F.lane * 4) = (u32x2){h0, h1};
            *(unsigned*)(ws + WS_WG + 2048 + (size_t)r * 4096 + i * 256 + F.lane * 4) = cvt4_fp8(v[0], v[1], v[2], v[3]);
            }
        ss = wave_sum(ss);
        if (F.lane < 8) ((float*)(ws + WS_SS))[(size_t)r * 8 + F.lane] = F.lane == 0 ? ss : 0.f;
    }
    rmsnorm_rows<false>(F, F.inp(1), F.inp(2), (bf16_t*)(ws + WS_MEMN), nullptr, NBATCH * NMEM);
    const int gt = F.wg * NTHREADS + F.tid, gn = F.G * NTHREADS;
    for (int i = gt; i < DEPTH * 4 * 128 * 128; i += gn) { const int s = i & 127, t = (i >> 7) & 127; ((bf16_t*)(ws + WS_GMW))[i] = f2bf(s <= t ? F.inp(20)[i] : 0.f); }
    float* tab = (float*)(ws + WS_TAB);
    for (int i = gt; i < 512; i += gn) {
        float v[DEPTH], mx = -1e30f, sum = 0.f;
#pragma unroll
        for (int l = 0; l < DEPTH; ++l) { v[l] = F.inp(5)[l * 512 + i]; mx = fmaxf(mx, v[l]); }
#pragma unroll
        for (int l = 0; l < DEPTH; ++l) { v[l] = __expf(v[l] - mx); sum += v[l]; }
        float cum = 0.f;
#pragma unroll
        for (int l = 0; l < DEPTH; ++l) { if (l > 0) cum += v[l] / sum; tab[TAB_LB / 4 + l * 512 + i] = cum; }
    }
    if (gt < DEPTH) { const int l = gt; float s1 = 0.f, s2 = 0.f;
        for (int i = 0; i < 64; ++i) { s1 += F.inp(7)[l * 64 + i] * F.inp(8)[l * 64 + i]; s2 += F.inp(9)[l * 64 + i] * F.inp(10)[l * 64 + i]; }
        const float linit = 0.8f - 0.6f * expf(-0.3f * (float)l);
        tab[TAB_LAM / 4 + l] = expf(s1) - expf(s2) + linit; }
    for (int i = F.wg * 8 + F.wave; i < DEPTH * 2 * 256; i += F.G * 8) { const int l = i >> 9, kv = (i >> 8) & 1, n = i & 255;
        const float* pos = F.inp(kv ? 15 : 12) + (size_t)l * 4096; const float* w1 = F.inp(kv ? 16 : 13) + (size_t)l * 4096 * 256 + n;
        float s = 0.f; for (int k = F.lane; k < 4096; k += 64) s += pos[k] * w1[(size_t)k * 256];
        s = wave_sum(s); if (F.lane == 0) tab[TAB_CBIAS / 4 + i] = s; }
}

__device__ __forceinline__ void compress2(const Frame& F, int l) {
    const bf16_t* HC = (const bf16_t*)(F.ws + WS_HC); const bf16_t* W2 = (const bf16_t*)(F.ws + WS_CW2) + (size_t)l * 2 * 128 * 256;
    const int r = F.lane & 15, q = F.lane >> 4;
    for (int tile = F.wg * 8 + F.wave; tile < 256; tile += F.G * 8) {
        const int kv = tile >> 7, r0 = (tile & 127) * 16;
        const bf16_t* ap = HC + ((size_t)kv * 2048 + r0 + r) * 256 + q * 8; const bf16_t* bp = W2 + (size_t)kv * 128 * 256 + (size_t)r * 256 + q * 8;
        bf16x8 a[8];
#pragma unroll
        for (int ks = 0; ks < 8; ++ks) a[ks] = *(const bf16x8*)(ap + ks * 32);
        bf16_t* op = (bf16_t*)(F.ws + (kv ? WS_VC : WS_KC)) + (size_t)r0 * 128;
#pragma unroll
        for (int nt = 0; nt < 8; ++nt) { f32x4 acc = (f32x4){0.f, 0.f, 0.f, 0.f};
#pragma unroll
            for (int ks = 0; ks < 8; ++ks) acc = __builtin_amdgcn_mfma_f32_16x16x32_bf16(a[ks], *(const bf16x8*)(bp + (size_t)nt * 16 * 256 + ks * 32), acc, 0, 0, 0);
#pragma unroll
            for (int i = 0; i < 4; ++i) op[(size_t)(4 * q + i) * 128 + nt * 16 + r] = f2bf(acc[i] * 1.0f); }
    }
}

__device__ __forceinline__ void xa_softmax(const Frame& F) {
    const float* S = (const float*)(F.ws + WS_S); bf16_t* Pq = (bf16_t*)(F.ws + WS_PXA);
    for (int r = F.wg * 8 + F.wave; r < MT; r += F.G * 8) {
        const float* sp = S + (size_t)r * 1024 + F.lane * 16; f32x4 v[4]; float mx = -1e30f;
#pragma unroll
        for (int i = 0; i < 4; ++i) { v[i] = *(const f32x4*)(sp + 4 * i); mx = fmaxf(mx, fmaxf(fmaxf(v[i][0], v[i][1]), fmaxf(v[i][2], v[i][3]))); }
#pragma unroll
        for (int o = 8; o >= 1; o >>= 1) mx = fmaxf(mx, __shfl_xor(mx, o));
        float sum = 0.f;
#pragma unroll
        for (int i = 0; i < 4; ++i)
#pragma unroll
            for (int e = 0; e < 4; ++e) { v[i][e] = __expf(v[i][e] - mx); sum += v[i][e]; }
#pragma unroll
        for (int o = 8; o >= 1; o >>= 1) sum += __shfl_xor(sum, o);
        const float inv = 1.f / sum;
        u32x4 o0 = (u32x4){cvtpk(v[0][0] * inv, v[0][1] * inv), cvtpk(v[0][2] * inv, v[0][3] * inv), cvtpk(v[1][0] * inv, v[1][1] * inv), cvtpk(v[1][2] * inv, v[1][3] * inv)};
        u32x4 o1 = (u32x4){cvtpk(v[2][0] * inv, v[2][1] * inv), cvtpk(v[2][2] * inv, v[2][3] * inv), cvtpk(v[3][0] * inv, v[3][1] * inv), cvtpk(v[3][2] * inv, v[3][3] * inv)};
        bf16_t* op = Pq + (size_t)r * 1024 + F.lane * 16; *(u32x4*)op = o0; *(u32x4*)(op + 8) = o1;
    }
}

__device__ __forceinline__ int q_next(const Frame& F, unsigned* ctr) {
    LAS int* slot = (LAS int*)(F.lds + LDS_BARW + 16);
    __syncthreads();
    if (F.tid == 0) *slot = (int)__hip_atomic_fetch_add(ctr, 1u, __ATOMIC_RELAXED, __HIP_MEMORY_SCOPE_AGENT);
    __syncthreads();
    return __builtin_amdgcn_readfirstlane(*slot);
}
__device__ __forceinline__ int q_issue(const Frame& F, unsigned* ctr) { { unsigned long long a_ = (unsigned long long)ctr; asm volatile("" : "+s"(a_)); ctr = (unsigned*)a_; }
    int v = 0; if (F.tid == 0) v = (int)__hip_atomic_fetch_add(ctr, 1u, __ATOMIC_RELAXED, __HIP_MEMORY_SCOPE_AGENT); return v; }
__device__ __forceinline__ void q_post(const Frame& F, int v) { if (F.tid == 0) *(LAS int*)(F.lds + LDS_BARW + 16) = v; }
__device__ __forceinline__ int q_read(const Frame& F) { __syncthreads(); return __builtin_amdgcn_readfirstlane(*(LAS int*)(F.lds + LDS_BARW + 16)); }
namespace at {
constexpr int SHM_K = 16384, SHM_V = 16384, OFF_V = 0, OFF_K = 32768, OFF_WS = 65536, OFF_END = 65536 + 2048;
constexpr float LOG2E = 1.4426950408889634f;
constexpr unsigned WINF = 0x40000000u;
#define KSWZ(row, colB) ((row) * 256 + ((colB) ^ (((row) & 7) << 4)))
#define SBAR() __builtin_amdgcn_sched_barrier(0)
__device__ __forceinline__ int v_st(int k, int c) { const int kk = (k & ~0xC) | ((k & 4) << 1) | ((k & 8) >> 1); return ((kk >> 3) * 4 + (c >> 5)) * 512 + ((kk & 7) * 32 + (c & 31)) * 2; }
__device__ __forceinline__ int v_rd_base(int lane) { return ((lane & 3) << 3) | (((lane >> 2) & 3) << 6) | (((lane >> 4) & 1) << 5) | (((lane >> 5) & 1) << 8); }
constexpr int v_rd_off(int d0, int ks, int half) { return d0 * 512 + ks * 4096 + half * 2048; }
__device__ __forceinline__ int crow(int r, int hi) { return (r & 3) + 8 * (r >> 2) + 4 * hi; }

__device__ __forceinline__ void mask_tile(f32x16& p0, f32x16& p1, int dq, unsigned W) {
    const float NEG = -__builtin_inff();
#pragma unroll
    for (int r = 0; r < 16; ++r) {
        const int c = (r & 3) + 8 * (r >> 2);
        if ((unsigned)(dq - c) >= W) p0[r] = NEG;
        if ((unsigned)(dq - c - 32) >= W) p1[r] = NEG;
    }
}
template <int NEXP = 16>
__device__ __forceinline__ void partialSM(f32x16& p0, f32x16& p1, float& m_reg, float& mn, float& alpha, float C2) {
    float pmax = p0[0];
#pragma unroll
    for (int r = 1; r < 16; ++r) pmax = fmaxf(pmax, p0[r]);
#pragma unroll
    for (int r = 0; r < 16; ++r) pmax = fmaxf(pmax, p1[r]);
    { auto rr = __builtin_amdgcn_permlane32_swap(__float_as_uint(pmax), __float_as_uint(pmax), false, false);
      pmax = fmaxf(__uint_as_float(rr[0]), __uint_as_float(rr[1])); }
    if (__builtin_expect(__all((pmax - m_reg) * C2 <= 11.5f), 1)) { mn = m_reg; alpha = 1.f; }
    else { mn = fmaxf(m_reg, pmax); alpha = __builtin_amdgcn_exp2f((m_reg - mn) * C2); m_reg = mn; }
    const float mnL = -mn * C2;
#pragma unroll
    for (int r = 0; r < 16; ++r) p0[r] = fmaf(p0[r], C2, mnL);
#pragma unroll
    for (int r = 0; r < 16; ++r) p1[r] = fmaf(p1[r], C2, mnL);
#pragma unroll
    for (int r = 0; r < NEXP; ++r) p0[r] = __builtin_amdgcn_exp2f(p0[r]);
}
#define PK4(P, B_, OUT) do { unsigned a0 = cvtpk(P[B_+0], P[B_+1]), a1 = cvtpk(P[B_+2], P[B_+3]);                          \
        unsigned b0 = cvtpk(P[B_+4], P[B_+5]), b1 = cvtpk(P[B_+6], P[B_+7]);                                             \
        auto r0 = __builtin_amdgcn_permlane32_swap(a0, b0, false, false); auto r1 = __builtin_amdgcn_permlane32_swap(a1, b1, false, false); \
        u32x4 w = {r0[0], r1[0], r0[1], r1[1]}; OUT = *reinterpret_cast<bf16x8*>(&w); } while (0)
__device__ __forceinline__ void pack_p(const f32x16& p0, const f32x16& p1, bf16x8& pa0, bf16x8& pa1, bf16x8& pa2, bf16x8& pa3) {
    PK4(p0, 0, pa0); PK4(p0, 8, pa1); PK4(p1, 0, pa2); PK4(p1, 8, pa3);
}
__device__ __forceinline__ void finishSM(f32x16& p0, f32x16& p1, float alpha, float& l_reg, bf16x8& pa0, bf16x8& pa1, bf16x8& pa2, bf16x8& pa3) {
#pragma unroll
    for (int r = 0; r < 16; ++r) p1[r] = __builtin_amdgcn_exp2f(p1[r]);
    float ps = 0;
#pragma unroll
    for (int r = 0; r < 16; ++r) ps += p0[r];
#pragma unroll
    for (int r = 0; r < 16; ++r) ps += p1[r];
    { auto rr = __builtin_amdgcn_permlane32_swap(__float_as_uint(ps), __float_as_uint(ps), false, false);
      ps = __uint_as_float(rr[0]) + __uint_as_float(rr[1]); }
    l_reg = l_reg * alpha + ps;
    pack_p(p0, p1, pa0, pa1, pa2, pa3);
}
template <int DN>
__device__ __forceinline__ void qkt(f32x16& p0, f32x16& p1, const LAS unsigned char* Kb, int r32, int hi, const bf16x8 (&qr)[DN], int kcoloff) {
    p0 = f32x16{}; p1 = f32x16{};
    const LAS unsigned char* kb[4];
#pragma unroll
    for (int dd = 0; dd < 4; ++dd) kb[dd] = Kb + kcoloff + KSWZ(r32, (dd * 16 + hi * 8) * 2);
#pragma unroll
    for (int d0 = 0; d0 < DN; ++d0) { const LAS unsigned char* a = kb[d0 & 3] + (d0 >> 2) * 128;
        const bf16x8 b0 = *reinterpret_cast<const LAS bf16x8*>(a);
        const bf16x8 b1 = *reinterpret_cast<const LAS bf16x8*>(a + 32 * 256);
        p0 = __builtin_amdgcn_mfma_f32_32x32x16_bf16(b0, qr[d0], p0, 0, 0, 0);
        p1 = __builtin_amdgcn_mfma_f32_32x32x16_bf16(b1, qr[d0], p1, 0, 0, 0); }
}
template <int VB>
__device__ __forceinline__ void pv_tile(f32x16 (&o)[4], int vb0, bf16x8 pa0, bf16x8 pa1, bf16x8 pa2, bf16x8 pa3) {
#define TRRD(dst, off) asm volatile("ds_read_b64_tr_b16 %0, %1 offset:%2" : "=&v"(dst) : "v"(vb0), "i"(off) : "memory")
#define PV_D0(d0) do { s16x4 l0, l1, l2, l3, h0, h1, h2, h3; constexpr int b_ = VB * SHM_V + v_rd_off(d0, 0, 0); \
        TRRD(l0, b_); TRRD(h0, b_ + 2048); TRRD(l1, b_ + 4096); TRRD(h1, b_ + 6144); TRRD(l2, b_ + 8192); TRRD(h2, b_ + 10240); TRRD(l3, b_ + 12288); TRRD(h3, b_ + 14336); \
        asm volatile("s_waitcnt lgkmcnt(0)" ::: "memory"); SBAR();   \
        o[d0] = __builtin_amdgcn_mfma_f32_32x32x16_bf16(pa0, (bf16x8){l0[0], l0[1], l0[2], l0[3], h0[0], h0[1], h0[2], h0[3]}, o[d0], 0, 0, 0);   \
        o[d0] = __builtin_amdgcn_mfma_f32_32x32x16_bf16(pa1, (bf16x8){l1[0], l1[1], l1[2], l1[3], h1[0], h1[1], h1[2], h1[3]}, o[d0], 0, 0, 0);   \
        o[d0] = __builtin_amdgcn_mfma_f32_32x32x16_bf16(pa2, (bf16x8){l2[0], l2[1], l2[2], l2[3], h2[0], h2[1], h2[2], h2[3]}, o[d0], 0, 0, 0);   \
        o[d0] = __builtin_amdgcn_mfma_f32_32x32x16_bf16(pa3, (bf16x8){l3[0], l3[1], l3[2], l3[3], h3[0], h3[1], h3[2], h3[3]}, o[d0], 0, 0, 0); } while (0)
    PV_D0(0); PV_D0(1); PV_D0(2); PV_D0(3);
#undef PV_D0
#undef TRRD
}
template <int VB>
__device__ __forceinline__ void finish_pv(f32x16& p0, f32x16& p1, float alpha, float& l_reg, f32x16 (&o)[4], int vb0,
                                          const bf16x8& sk0, const bf16x8& sk1, const bf16x8& sv0, const bf16x8& sv1, LAS unsigned char* wk, LAS unsigned char* wv0, LAS unsigned char* wv1) {
#define TRRD(dst, off) asm volatile("ds_read_b64_tr_b16 %0, %1 offset:%2" : "=&v"(dst) : "v"(vb0), "i"(off) : "memory")
#define FPV_RD(L_, H_, g) do { _Pragma("unroll") for (int d_ = 0; d_ < 4; ++d_) { } TRRD(L_[0], VB * SHM_V + v_rd_off(0, 0, 0) + (g) * 4096); TRRD(H_[0], VB * SHM_V + v_rd_off(0, 0, 0) + (g) * 4096 + 2048); \
        TRRD(L_[1], VB * SHM_V + v_rd_off(1, 0, 0) + (g) * 4096); TRRD(H_[1], VB * SHM_V + v_rd_off(1, 0, 0) + (g) * 4096 + 2048);              \
        TRRD(L_[2], VB * SHM_V + v_rd_off(2, 0, 0) + (g) * 4096); TRRD(H_[2], VB * SHM_V + v_rd_off(2, 0, 0) + (g) * 4096 + 2048);              \
        TRRD(L_[3], VB * SHM_V + v_rd_off(3, 0, 0) + (g) * 4096); TRRD(H_[3], VB * SHM_V + v_rd_off(3, 0, 0) + (g) * 4096 + 2048); } while (0)
#define FPV_MMA(PA, L_, H_, d0) o[d0] = __builtin_amdgcn_mfma_f32_32x32x16_bf16(PA, (bf16x8){L_[d0][0], L_[d0][1], L_[d0][2], L_[d0][3], H_[d0][0], H_[d0][1], H_[d0][2], H_[d0][3]}, o[d0], 0, 0, 0)
#define FPV_WAIT() do { asm volatile("s_waitcnt lgkmcnt(0)" ::: "memory"); SBAR(); } while (0)
    bf16x8 pa; float ps = 0.f;
    s16x4 la[4], ha[4], lb[4], hb[4];
    FPV_RD(la, ha, 0); PK4(p0, 0, pa); FPV_WAIT();
    FPV_RD(lb, hb, 1);
    FPV_MMA(pa, la, ha, 0); p0[8] = __builtin_amdgcn_exp2f(p0[8]); p0[9] = __builtin_amdgcn_exp2f(p0[9]); ps += p0[0]; ps += p0[1]; SBAR();
    FPV_MMA(pa, la, ha, 1); p0[10] = __builtin_amdgcn_exp2f(p0[10]); p0[11] = __builtin_amdgcn_exp2f(p0[11]); ps += p0[2]; ps += p0[3]; SBAR();
    FPV_MMA(pa, la, ha, 2); p0[12] = __builtin_amdgcn_exp2f(p0[12]); p0[13] = __builtin_amdgcn_exp2f(p0[13]); ps += p0[4]; ps += p0[5]; SBAR();
    FPV_MMA(pa, la, ha, 3); p0[14] = __builtin_amdgcn_exp2f(p0[14]); p0[15] = __builtin_amdgcn_exp2f(p0[15]); ps += p0[6]; ps += p0[7]; SBAR();
    PK4(p0, 8, pa); FPV_WAIT();
    FPV_RD(la, ha, 2);
    FPV_MMA(pa, lb, hb, 0); p1[0] = __builtin_amdgcn_exp2f(p1[0]); p1[1] = __builtin_amdgcn_exp2f(p1[1]); ps += p0[8]; ps += p0[9]; SBAR();
    FPV_MMA(pa, lb, hb, 1); p1[2] = __builtin_amdgcn_exp2f(p1[2]); p1[3] = __builtin_amdgcn_exp2f(p1[3]); ps += p0[10]; ps += p0[11]; SBAR();
    FPV_MMA(pa, lb, hb, 2); p1[4] = __builtin_amdgcn_exp2f(p1[4]); p1[5] = __builtin_amdgcn_exp2f(p1[5]); ps += p0[12]; ps += p0[13]; SBAR();
    FPV_MMA(pa, lb, hb, 3); p1[6] = __builtin_amdgcn_exp2f(p1[6]); p1[7] = __builtin_amdgcn_exp2f(p1[7]); ps += p0[14]; ps += p0[15]; SBAR();
    PK4(p1, 0, pa); FPV_WAIT();
    FPV_RD(lb, hb, 3);
    FPV_MMA(pa, la, ha, 0); p1[8] = __builtin_amdgcn_exp2f(p1[8]); p1[9] = __builtin_amdgcn_exp2f(p1[9]); ps += p1[0]; ps += p1[1]; *(LAS bf16x8*)wk = sk0; SBAR();
    FPV_MMA(pa, la, ha, 1); p1[10] = __builtin_amdgcn_exp2f(p1[10]); p1[11] = __builtin_amdgcn_exp2f(p1[11]); ps += p1[2]; ps += p1[3]; *(LAS bf16x8*)(wk + 32 * 256) = sk1; SBAR();
    FPV_MMA(pa, la, ha, 2); p1[12] = __builtin_amdgcn_exp2f(p1[12]); p1[13] = __builtin_amdgcn_exp2f(p1[13]); ps += p1[4]; ps += p1[5]; SBAR();
    FPV_MMA(pa, la, ha, 3); p1[14] = __builtin_amdgcn_exp2f(p1[14]); p1[15] = __builtin_amdgcn_exp2f(p1[15]); ps += p1[6]; ps += p1[7]; SBAR();
    PK4(p1, 8, pa); FPV_WAIT();
    FPV_MMA(pa, lb, hb, 0); ps += p1[8]; ps += p1[9]; *(LAS bf16x8*)wv0 = sv0; SBAR();
    FPV_MMA(pa, lb, hb, 1); ps += p1[10]; ps += p1[11]; *(LAS bf16x8*)wv1 = sv1; SBAR();
    FPV_MMA(pa, lb, hb, 2); ps += p1[12]; ps += p1[13]; SBAR();
    FPV_MMA(pa, lb, hb, 3); ps += p1[14]; ps += p1[15]; SBAR();
    { auto rr = __builtin_amdgcn_permlane32_swap(__float_as_uint(ps), __float_as_uint(ps), false, false);
      ps = __uint_as_float(rr[0]) + __uint_as_float(rr[1]); }
    l_reg = l_reg * alpha + ps;
#undef FPV_RD
#undef FPV_MMA
#undef FPV_WAIT
#undef TRRD
}
struct Stg { bf16x8 k0, k1, v0, v1; };
__device__ __forceinline__ void stg_load(Stg& s, const bf16_t* Kg, size_t ldk, const bf16_t* Vg, size_t ldv, int kb, int sr, int sc) {
    s.k0 = *(const bf16x8*)(Kg + (size_t)(kb + sr) * ldk + sc); s.k1 = *(const bf16x8*)(Kg + (size_t)(kb + 32 + sr) * ldk + sc);
    s.v0 = *(const bf16x8*)(Vg + (size_t)(kb + sr) * ldv + sc); s.v1 = *(const bf16x8*)(Vg + (size_t)(kb + 32 + sr) * ldv + sc);
}
__device__ __forceinline__ void stg_write(const Stg& s, LAS unsigned char* lds, int buf, int kws, int vst0, int vst1) {
    *(LAS bf16x8*)(lds + OFF_K + buf * SHM_K + kws) = s.k0; *(LAS bf16x8*)(lds + OFF_K + buf * SHM_K + kws + 32 * 256) = s.k1;
    *(LAS bf16x8*)(lds + OFF_V + buf * SHM_V + vst0) = s.v0; *(LAS bf16x8*)(lds + OFF_V + buf * SHM_V + vst1) = s.v1;
}
struct Lane { int tid, wid, lane, r32, hi, sr, sc, kws, vst0, vst1, vb0; LAS float* li_l; LAS float* al_l; };
__device__ __forceinline__ Lane make_lane(LAS unsigned char* lds, int tid) {
    Lane L; L.tid = tid; L.wid = __builtin_amdgcn_readfirstlane(L.tid >> 6); L.lane = L.tid & 63; L.r32 = L.lane & 31; L.hi = L.lane >> 5;
    L.sr = L.tid >> 4; L.sc = (L.tid & 15) * 8; L.kws = KSWZ(L.sr, L.sc * 2); L.vst0 = v_st(L.sr, L.sc); L.vst1 = v_st(32 + L.sr, L.sc);
    L.vb0 = (int)(unsigned)(uintptr_t)(lds + OFF_V) + v_rd_base(L.lane);
    L.li_l = (LAS float*)(lds + OFF_WS) + L.wid * 64; L.al_l = L.li_l + 32; return L;
}
#define AT_RESC(a) do { if (__any((a) < 1.f)) { if (L.hi == 0) L.al_l[L.r32] = (a); asm volatile("s_waitcnt lgkmcnt(0)" ::: "memory");              \
        _Pragma("unroll") for (int d_ = 0; d_ < 4; ++d_) _Pragma("unroll") for (int r = 0; r < 16; ++r) o[d_][r] *= L.al_l[crow(r, L.hi)]; } } while (0)

template <int DN, int MODE, bool DO_PV>
__device__ __forceinline__ void attn_run(LAS unsigned char* lds, const Lane& L, const bf16_t* Kg, size_t ldk, const bf16_t* Vg, size_t ldv, int kt_lo, int kt_hi,
                                         const bf16x8 (&qr)[DN], int kcoloff, int rpos, int rmin, int rmax, unsigned W, const LAS unsigned* selp, float C2,
                                         float& m_reg, float& l_reg, f32x16 (&o)[4]) {
    Stg st; f32x16 p0, p1; bf16x8 pa0, pa1, pa2, pa3; float mn, alpha; unsigned selcur = 0u;
    if (kt_lo >= kt_hi) return;
    stg_load(st, Kg, ldk, Vg, ldv, kt_lo * 64, L.sr, L.sc);
    stg_write(st, lds, 0, L.kws, L.vst0, L.vst1);
    __syncthreads();
#define AT_STEP(t, B) do { const int kb_ = (t) * 64; const bool hn_ = (t) + 1 < kt_hi;                                                       \
        if (hn_) stg_load(st, Kg, ldk, Vg, ldv, kb_ + 64, L.sr, L.sc);                                                                        \
        bool act_ = (rmax >= kb_) && (rmin - (kb_ + 63) < (int)W);                                                                            \
        bool nm_ = !((rmin >= kb_ + 63) && (rmax - kb_ < (int)W)); unsigned Wl_ = W; bool sb_ = true, kill_ = false;                          \
        if (MODE == 1) { if (((t) & 31) == 0) selcur = selp[(t) >> 5]; sb_ = (selcur >> ((t) & 31)) & 1u;                                     \
                         Wl_ = sb_ ? W : 0u; act_ = act_ && __any(sb_); kill_ = !nm_ && !__all(sb_); }                                       \
        if (act_) { qkt<DN>(p0, p1, lds + OFF_K + (B) * SHM_K, L.r32, L.hi, qr, kcoloff);                                                     \
            if (nm_) mask_tile(p0, p1, rpos - kb_ - 4 * L.hi, Wl_);                                                                           \
            else if (kill_) { const float ninf_ = -__builtin_inff();     \
                _Pragma("unroll") for (int r = 0; r < 16; ++r) { p0[r] = sb_ ? p0[r] : ninf_; p1[r] = sb_ ? p1[r] : ninf_; } }                 \
            partialSM<DO_PV ? 8 : 16>(p0, p1, m_reg, mn, alpha, C2);                                                                           \
            if (DO_PV) AT_RESC(alpha);                                                                                                        \
            if (DO_PV) finish_pv<B>(p0, p1, alpha, l_reg, o, L.vb0, st.k0, st.k1, st.v0, st.v1, lds + OFF_K + (1 - (B)) * SHM_K + L.kws,      \
                                    lds + OFF_V + (1 - (B)) * SHM_V + L.vst0, lds + OFF_V + (1 - (B)) * SHM_V + L.vst1);                      \
            else finishSM(p0, p1, alpha, l_reg, pa0, pa1, pa2, pa3); }                                                                        \
        if (hn_ && !(DO_PV && act_)) stg_write(st, lds, 1 - (B), L.kws, L.vst0, L.vst1);                                                      \
        __syncthreads(); } while (0)
    for (int t = kt_lo; t < kt_hi; t += 2) {
        AT_STEP(t, 0);
        if (t + 1 < kt_hi) AT_STEP(t + 1, 1);
        else {
        }
    }
#undef AT_STEP
}
__device__ __forceinline__ void row_inv_l(const Lane& L, float l_reg, float (&rli)[16]) {
    if (L.hi == 0) L.li_l[L.r32] = l_reg; asm volatile("s_waitcnt lgkmcnt(0)" ::: "memory");
#pragma unroll
    for (int r = 0; r < 16; ++r) { const float lv = L.li_l[crow(r, L.hi)]; rli[r] = lv > 0.f ? __builtin_amdgcn_rcpf(lv) : 0.f; }
}

__device__ __forceinline__ void diff_attn_item(const Frame& F, int layer, int bh, int qt, unsigned* qctr) {
    LAS unsigned char* lds = F.lds; const Lane L = make_lane(lds, F.tid);
    const bf16_t* P = (const bf16_t*)(F.ws + WS_P); bf16_t* OALL = (bf16_t*)(F.ws + WS_OALL);
    const float lam = ((const float*)(F.ws + WS_TAB))[TAB_LAM / 4 + layer];
    const float linit = 0.8f - 0.6f * expf(-0.3f * (float)layer);
    const float* nw = F.inp(11) + layer * 128;
    const int map = L.wid >> 2, wq = L.wid & 3;
    LAS float* OB = (LAS float*)lds;
    const int b = bh >> 2, h = bh & 3;
    const int tok0 = qt * 128 + wq * 32, pos = tok0 + L.r32;
    const bf16_t* Pb = P + (size_t)b * SEQ * NP;
    bf16x8 qr[4];
#pragma unroll
    for (int i = 0; i < 4; ++i) qr[i] = *(const bf16x8*)(Pb + (size_t)pos * NP + C_DQ + h * 128 + map * 64 + i * 16 + L.hi * 8);
    float m_reg = -1e30f, l_reg = 0.f; f32x16 o[4] = {};
    attn_run<4, 0, true>(lds, L, Pb + C_DK + h * 128, NP, Pb + C_DV + h * 128, NP, 0, 2 * qt + 2, qr, map * 128, pos, tok0, tok0 + 31, WINF, (const LAS unsigned*)nullptr,
                         LOG2E * 0.125f, m_reg, l_reg, o);
    const int qn = q_issue(F, qctr);
    float rli[16]; row_inv_l(L, l_reg, rli);
    __syncthreads();
#pragma unroll
    for (int r = 0; r < 16; ++r) { const int row = wq * 32 + crow(r, L.hi);
#pragma unroll
        for (int d0 = 0; d0 < 4; ++d0) OB[(map * 128 + row) * 132 + d0 * 32 + L.r32] = o[d0][r] * rli[r]; }
    __syncthreads();
    { const int t = F.tid >> 2, q4 = F.tid & 3; float v[32]; float ss = 0.f;
#pragma unroll
      for (int j = 0; j < 32; ++j) { v[j] = OB[t * 132 + q4 * 32 + j] - lam * OB[(128 + t) * 132 + q4 * 32 + j]; ss += v[j] * v[j]; }
      ss += __shfl_xor(ss, 1); ss += __shfl_xor(ss, 2);
      const float rs = rsqrtf(ss * (1.f / 128.f) + 1e-6f) * (1.f - linit);
      bf16_t* op = OALL + ((size_t)b * SEQ + qt * 128 + t) * DM + 512 + h * 128 + q4 * 32;
#pragma unroll
      for (int j = 0; j < 32; j += 8)
          *(u32x4*)(op + j) = (u32x4){cvtpk(v[j] * rs * nw[q4 * 32 + j], v[j + 1] * rs * nw[q4 * 32 + j + 1]), cvtpk(v[j + 2] * rs * nw[q4 * 32 + j + 2], v[j + 3] * rs * nw[q4 * 32 + j + 3]),
                                      cvtpk(v[j + 4] * rs * nw[q4 * 32 + j + 4], v[j + 5] * rs * nw[q4 * 32 + j + 5]), cvtpk(v[j + 6] * rs * nw[q4 * 32 + j + 6], v[j + 7] * rs * nw[q4 * 32 + j + 7])}; }
    __syncthreads();
    q_post(F, qn);
}

constexpr int NS_PT = OFF_END, NS_IMP = NS_PT + 8 * 2304, NS_SEL = NS_IMP + 64 * 256 * 4, NS_END = NS_SEL + 64 * 8 * 4;
__device__ __forceinline__ void nsa_item(const Frame& F, int b, int c, unsigned* qctr) {
    LAS unsigned char* lds = F.lds; const Lane L = make_lane(lds, F.tid);
    const bf16_t* P = (const bf16_t*)(F.ws + WS_P); const bf16_t* KC = (const bf16_t*)(F.ws + WS_KC); const bf16_t* VC = (const bf16_t*)(F.ws + WS_VC);
    bf16_t* OALL = (bf16_t*)(F.ws + WS_OALL); float* NACC = (float*)(F.ws + WS_NACC);
    LAS float* PT = (LAS float*)(lds + NS_PT) + L.wid * 576;
    LAS float* IMP = (LAS float*)(lds + NS_IMP);
    LAS unsigned* SELL = (LAS unsigned*)(lds + NS_SEL);
    const float C2 = LOG2E * 0.08838834764831845f;
    const int tk = L.r32 >> 2, head = L.r32 & 3;
    const int tokw = c * 64 + L.wid * 8, pos = tokw + tk;
    const size_t grow = (size_t)b * SEQ + pos;
    const bf16_t* Pb = P + (size_t)b * SEQ * NP;
    bf16x8 qr[8];
#pragma unroll
    for (int i = 0; i < 8; ++i) qr[i] = *(const bf16x8*)(P + grow * NP + C_NQ + head * 128 + i * 16 + L.hi * 8);
    const int nt = ((4 * c + 3) + 63) >> 6;
    {
        const int rpos = (pos - 31) >> 4, rmin = (tokw - 31) >> 4, rmax = (tokw + 7 - 31) >> 4;
        const bf16_t* Kg = KC + (size_t)b * 1024 * 128; const bf16_t* Vg = VC + (size_t)b * 1024 * 128;
        float m_reg = -1e30f, l_reg = 0.f; f32x16 o[4] = {};
        attn_run<8, 0, false>(lds, L, Kg, 128, Vg, 128, 0, nt, qr, 0, rpos, rmin, rmax, WINF, (const LAS unsigned*)nullptr, C2, m_reg, l_reg, o);
        const float invl = l_reg > 0.f ? 1.f / l_reg : 0.f, mnL = -m_reg * C2;
        Stg st; f32x16 p0, p1; bf16x8 pa0, pa1, pa2, pa3;
        if (L.lane < 8) PT[512 + L.lane] = 0.f;
        stg_load(st, Kg, 128, Vg, 128, 0, L.sr, L.sc); stg_write(st, lds, 0, L.kws, L.vst0, L.vst1); __syncthreads();
#define CMP_STEP(t, B) do { const int kb_ = (t) * 64; const bool hn_ = (t) + 1 < nt;                                                         \
        if (hn_) stg_load(st, Kg, 128, Vg, 128, kb_ + 64, L.sr, L.sc);                                                                        \
        qkt<8>(p0, p1, lds + OFF_K + (B) * SHM_K, L.r32, L.hi, qr, 0);                                                                        \
        mask_tile(p0, p1, rpos - kb_ - 4 * L.hi, WINF);                                                                                       \
        _Pragma("unroll") for (int r = 0; r < 16; ++r) { p0[r] = __builtin_amdgcn_exp2f(fmaf(p0[r], C2, mnL)) * invl; p1[r] = __builtin_amdgcn_exp2f(fmaf(p1[r], C2, mnL)) * invl; } \
        _Pragma("unroll") for (int q = 0; q < 4; ++q) { f32x4 s0, s1;                                                                        \
            _Pragma("unroll") for (int e = 0; e < 4; ++e) { float a0 = p0[4 * q + e], a1 = p1[4 * q + e];                                    \
                a0 += __shfl_xor(a0, 1); a0 += __shfl_xor(a0, 2); a1 += __shfl_xor(a1, 1); a1 += __shfl_xor(a1, 2); s0[e] = a0; s1[e] = a1; } \
            if (head == 0) { *(LAS f32x4*)(PT + tk * 64 + 4 * L.hi + 8 * q) = s0; *(LAS f32x4*)(PT + tk * 64 + 4 * L.hi + 32 + 8 * q) = s1; } } \
        asm volatile("s_waitcnt lgkmcnt(0)" ::: "memory");                                                                                    \
        _Pragma("unroll") for (int x = 0; x < 2; ++x) { const int e_ = L.lane + 64 * x, tk_ = e_ >> 4, jb_ = e_ & 15; LAS float* pr_ = PT + tk_ * 64 + 4 * jb_; \
            const float pm1_ = jb_ == 0 ? PT[512 + tk_] : pr_[-1];                                                                            \
            IMP[(L.wid * 8 + tk_) * 256 + 16 * (t) + jb_] = pm1_ + 2.f * pr_[0] + 2.f * pr_[1] + 2.f * pr_[2] + pr_[3]; }                     \
        asm volatile("s_waitcnt lgkmcnt(0)" ::: "memory");                                                                                    \
        if (L.lane < 8) PT[512 + L.lane] = PT[L.lane * 64 + 63];                                                                              \
        pack_p(p0, p1, pa0, pa1, pa2, pa3); pv_tile<B>(o, L.vb0, pa0, pa1, pa2, pa3);                                                         \
        if (hn_) stg_write(st, lds, 1 - (B), L.kws, L.vst0, L.vst1);                                                                          \
        __syncthreads(); } while (0)
        for (int t = 0; t < nt; t += 2) { CMP_STEP(t, 0); if (t + 1 < nt) CMP_STEP(t + 1, 1); }
#undef CMP_STEP
#pragma unroll
        for (int r = 0; r < 16; ++r) { const int row = crow(r, L.hi), tk2 = row >> 2, hd = row & 3;
            const size_t gr = (size_t)b * SEQ + tokw + tk2;
            const float g = sigmoidf_(bf2f(P[gr * NP + C_NG + hd * 3 + 0]));
#pragma unroll
            for (int d0 = 0; d0 < 4; ++d0) NACC[gr * 512 + hd * 128 + d0 * 32 + L.r32] = g * o[d0][r]; }
    }
    for (int t8 = 0; t8 < 8; ++t8) {
        const int row = L.wid * 8 + t8, cur = c;
        f32x4 iv = (f32x4){0.f, 0.f, 0.f, 0.f};
        if (L.lane * 4 < 16 * nt) iv = *(const LAS f32x4*)(IMP + row * 256 + L.lane * 4);
        float sc[4];
#pragma unroll
        for (int i = 0; i < 4; ++i) { const int j = L.lane * 4 + i; const bool valid = j <= cur, forced = (j == 0) || (j > cur - 2);
            sc[i] = valid ? (forced ? 1e4f : iv[i]) : -1.f; }
        unsigned nib = 0u;
        for (int round = 0; round < 16; ++round) {
            const float best = fmaxf(fmaxf(sc[0], sc[1]), fmaxf(sc[2], sc[3]));
            const float wmax = wave_max(best);
            if (wmax < 0.f) break;
            const unsigned long long bal = __ballot(best == wmax);
            const int win = __ffsll((long long)bal) - 1;
            if (L.lane == win) {
                if (sc[0] == wmax) { sc[0] = -2.f; nib |= 1u; }
                else if (sc[1] == wmax) { sc[1] = -2.f; nib |= 2u; }
                else if (sc[2] == wmax) { sc[2] = -2.f; nib |= 4u; }
                else { sc[3] = -2.f; nib |= 8u; }
            }
        }
        unsigned word = nib << (4 * (L.lane & 7));
        word |= __shfl_xor(word, 1); word |= __shfl_xor(word, 2); word |= __shfl_xor(word, 4);
        if ((L.lane & 7) == 0) SELL[row * 8 + (L.lane >> 3)] = word;
    }
    asm volatile("s_waitcnt lgkmcnt(0)" ::: "memory");
    {
        float m_reg = -1e30f, l_reg = 0.f; f32x16 o[4] = {};
        attn_run<8, 1, true>(lds, L, Pb + C_KS, NP, Pb + C_VS, NP, 0, c + 1, qr, 0, pos, tokw, tokw + 7, WINF, (const LAS unsigned*)(SELL + (L.wid * 8 + tk) * 8), C2, m_reg, l_reg, o);
        float rli[16]; row_inv_l(L, l_reg, rli);
#pragma unroll
        for (int r = 0; r < 16; ++r) { const int row = crow(r, L.hi), tk2 = row >> 2, hd = row & 3;
            const size_t gr = (size_t)b * SEQ + tokw + tk2;
            const float g = sigmoidf_(bf2f(P[gr * NP + C_NG + hd * 3 + 1])) * rli[r];
#pragma unroll
            for (int d0 = 0; d0 < 4; ++d0) NACC[gr * 512 + hd * 128 + d0 * 32 + L.r32] += g * o[d0][r]; }
    }
    {
        float m_reg = -1e30f, l_reg = 0.f; f32x16 o[4] = {};
        attn_run<8, 0, true>(lds, L, Pb + C_KW, NP, Pb + C_VW, NP, c >= 8 ? c - 8 : 0, c + 1, qr, 0, pos, tokw, tokw + 7, 512u, (const LAS unsigned*)nullptr, C2, m_reg, l_reg, o);
        const int qn = q_issue(F, qctr);
        float rli[16]; row_inv_l(L, l_reg, rli);
#pragma unroll
        for (int r = 0; r < 16; ++r) { const int row = crow(r, L.hi), tk2 = row >> 2, hd = row & 3;
            const size_t gr = (size_t)b * SEQ + tokw + tk2;
            const float g = sigmoidf_(bf2f(P[gr * NP + C_NG + hd * 3 + 2])) * rli[r];
#pragma unroll
            for (int d0 = 0; d0 < 4; ++d0) { const float v = NACC[gr * 512 + hd * 128 + d0 * 32 + L.r32] + g * o[d0][r];
                OALL[gr * DM + 1024 + hd * 128 + d0 * 32 + L.r32] = f2bf(v); } }
        q_post(F, qn);
    }
}
}
__device__ __forceinline__ f32x4 mma16(bf16x8 a, bf16x8 b, f32x4 c) { return __builtin_amdgcn_mfma_f32_16x16x32_bf16(a, b, c, 0, 0, 0); }

#define HG_CUMSUM(GSUM)                                                                                                                        \
    bf16_t flr[16];                                                                                                                            \
    _Pragma("unroll") for (int i = 0; i < 16; ++i) flr[i] = Pc[(size_t)(rg * 16 + i) * NP + C_HF + h * 128 + col];                             \
    HG_CUMSUM_PRE(GSUM)
#define HG_CUMSUM_PRE(GSUM)                                                                                                                    \
    float bc[16], kk[16]; float run = 0.f;                                                                                                     \
    _Pragma("unroll") for (int i = 0; i < 16; ++i) {                                                                                           \
        const float fl = bf2f(flr[i]); const float f = lb + (1.f - lb) * sigmoidf_(fl);                                                        \
        run += __logf(f); bc[i] = run; kk[i] = 1.f - f; }                                                                                      \
    GSUM[rg * 128 + col] = run; __syncthreads();                                                                                               \
    float pre = 0.f, total = 0.f;                                                                                                              \
    _Pragma("unroll") for (int g2 = 0; g2 < 4; ++g2) { const float gs = GSUM[g2 * 128 + col]; total += gs; if (g2 < rg) pre += gs; }           \
    _Pragma("unroll") for (int i = 0; i < 16; ++i) bc[i] += pre;

__device__ __forceinline__ void hgrn_local(const Frame& F, int layer, int it0, int it1, int its, unsigned* qctr) {
    LAS unsigned char* lds = F.lds;
    LAS bf16_t* kT = (LAS bf16_t*)lds; LAS bf16_t* vT = (LAS bf16_t*)(lds + 18432); LAS float* GS = (LAS float*)(lds + 36864);
    const bf16_t* P = (const bf16_t*)(F.ws + WS_P); bf16_t* HST = (bf16_t*)(F.ws + WS_HST); float* HD = (float*)(F.ws + WS_HD);
    const float* LB = (const float*)(F.ws + WS_TAB) + TAB_LB / 4 + layer * 512;
    const int col = F.tid & 127, rg = F.tid >> 7, r = F.lane & 15, q = F.lane >> 4;
    bf16_t vr[16], flr[16];
#define HGL_LOAD_ROWS(item_) do { const int bh_ = (item_) >> 8, c_ = (item_) & 255, b_ = bh_ >> 2, h_ = bh_ & 3; const bf16_t* Pn_ = P + ((size_t)b_ * SEQ + c_ * 64) * NP;      \
        _Pragma("unroll") for (int i = 0; i < 16; ++i) { const bf16_t* rowp = Pn_ + (size_t)(rg * 16 + i) * NP; vr[i] = rowp[C_HI + h_ * 128 + col]; flr[i] = rowp[C_HF + h_ * 128 + col]; } } while (0)
    if (it0 < it1) HGL_LOAD_ROWS(it0);
    int qn = 0;
    for (int item = it0; item < it1; item += its) {
        if (item + its >= it1) qn = q_issue(F, qctr);
        const int bh = item >> 8, h = bh & 3;
        const float lb = LB[h * 128 + col];
        HG_CUMSUM_PRE(GS)
#pragma unroll
        for (int i = 0; i < 16; ++i) { const int t = rg * 16 + i;
            kT[col * 72 + t] = f2bf(kk[i] * __expf(total - bc[i]));
            vT[col * 72 + t] = vr[i]; }
        if (rg == 0) HD[(size_t)item * 128 + col] = __expf(total);
        if (item + its < it1) HGL_LOAD_ROWS(item + its);
        __syncthreads();
        {   const int w = F.wave;
            bf16x8 a0 = *(const LAS bf16x8*)(vT + (16 * w + r) * 72 + q * 8), a1 = *(const LAS bf16x8*)(vT + (16 * w + r) * 72 + 32 + q * 8);
#pragma unroll
            for (int kt8 = 0; kt8 < 8; ++kt8) {
                f32x4 acc = (f32x4){0.f, 0.f, 0.f, 0.f};
                acc = mma16(a0, *(const LAS bf16x8*)(kT + (16 * kt8 + r) * 72 + q * 8), acc);
                acc = mma16(a1, *(const LAS bf16x8*)(kT + (16 * kt8 + r) * 72 + 32 + q * 8), acc);
#pragma unroll
                for (int i = 0; i < 4; ++i) HST[(size_t)item * 16384 + (16 * w + 4 * q + i) * 128 + 16 * kt8 + r] = f2bf(acc[i] * 1.0f);
            } }
        __syncthreads();
    }
    q_post(F, qn);
}
#undef HGL_LOAD_ROWS
__device__ __forceinline__ void hgrn_scan(const Frame& F) {
    bf16_t* HST = (bf16_t*)(F.ws + WS_HST); const float* HD = (const float*)(F.ws + WS_HD);
    for (int idx = F.wg * NTHREADS + F.tid; idx < 8 * 16384; idx += F.G * NTHREADS) {
        const int bh = idx >> 14, e = idx & 16383, kc = e & 127;
        bf16_t* hp = HST + (size_t)bh * 256 * 16384 + e; const float* dp = HD + (size_t)bh * 256 * 128 + kc;
        float state = 0.f; float d[8], dn[8]; bf16_t u[8], un[8];
#pragma unroll
        for (int j = 0; j < 8; ++j) { u[j] = hp[(size_t)j * 16384]; d[j] = dp[(size_t)j * 128]; }
        for (int c = 0; c < 256; c += 8) {
            const int cn = (c + 8 < 256) ? c + 8 : c;
#pragma unroll
            for (int j = 0; j < 8; ++j) { un[j] = hp[(size_t)(cn + j) * 16384]; dn[j] = dp[(size_t)(cn + j) * 128]; }
#pragma unroll
            for (int j = 0; j < 8; ++j) { hp[(size_t)(c + j) * 16384] = f2bf(state); state = d[j] * state + bf2f(u[j]); }
#pragma unroll
            for (int j = 0; j < 8; ++j) { u[j] = un[j]; d[j] = dn[j]; }
        }
    }
}
__device__ __forceinline__ void hgrn_out(const Frame& F, int layer, int it0, int it1, int its, unsigned* qctr) {
    LAS unsigned char* lds = F.lds;
    LAS float* bL = (LAS float*)lds;
    LAS bf16_t* qL = (LAS bf16_t*)(lds + 33024);
    LAS bf16_t* kL = (LAS bf16_t*)(lds + 50432);
    LAS bf16_t* qS = (LAS bf16_t*)(lds + 67840);
    LAS bf16_t* sT = (LAS bf16_t*)(lds + 85248);
    LAS bf16_t* stg = (LAS bf16_t*)(lds + 85248);
    LAS bf16_t* vT = (LAS bf16_t*)(lds + 120064);
    LAS bf16_t* sc = (LAS bf16_t*)(lds + 138496);
    LAS float* GS = (LAS float*)(lds + 147712);
    LAS float* oL = (LAS float*)lds;
    const bf16_t* P = (const bf16_t*)(F.ws + WS_P); const bf16_t* HST = (const bf16_t*)(F.ws + WS_HST); bf16_t* OALL = (bf16_t*)(F.ws + WS_OALL);
    const float* LB = (const float*)(F.ws + WS_TAB) + TAB_LB / 4 + layer * 512; const float* nw = F.inp(6) + layer * 128;
    const int col = F.tid & 127, rg = F.tid >> 7, r = F.lane & 15, q = F.lane >> 4;
    u32x4 st4[4];
    bf16_t qr[16], vr[16], flr[16];
#define HGO_LOAD_ROWS(item_) do { const int bh_ = (item_) >> 8, c_ = (item_) & 255, b_ = bh_ >> 2, h_ = bh_ & 3; const bf16_t* Pn_ = P + ((size_t)b_ * SEQ + c_ * 64) * NP;      \
        int rg_ = rg; asm volatile("" : "+v"(rg_));                                                \
        _Pragma("unroll") for (int i = 0; i < 16; ++i) { const bf16_t* rowp = Pn_ + (size_t)(rg_ * 16 + i) * NP; qr[i] = rowp[C_HQ + h_ * 128 + col]; vr[i] = rowp[C_HI + h_ * 128 + col]; \
            flr[i] = rowp[C_HF + h_ * 128 + col]; } } while (0)
#define HGO_LOAD_STATE(item_) do { _Pragma("unroll") for (int j = 0; j < 4; ++j) st4[j] = *(const u32x4*)(HST + (size_t)(item_) * 16384 + (j * NTHREADS + F.tid) * 8); } while (0)
    if (it0 < it1) { HGO_LOAD_STATE(it0); HGO_LOAD_ROWS(it0); }
    int qn = 0;
    for (int item = it0; item < it1; item += its) {
        if (item + its >= it1) qn = q_issue(F, qctr);
        const int bh = item >> 8, c = item & 255, b = bh >> 2, h = bh & 3;
        const float lb = LB[h * 128 + col];
        for (int i = F.tid; i < 64 * 72 / 2; i += NTHREADS) ((LAS unsigned*)sc)[i] = 0u;
        HG_CUMSUM_PRE(GS)
        (void)total;
#pragma unroll
        for (int i = 0; i < 16; ++i) { const int t = rg * 16 + i;
            const float qv = siluf_(bf2f(qr[i]));
            bL[t * 129 + col] = bc[i]; qL[t * 136 + col] = f2bf(qv); kL[t * 136 + col] = f2bf(kk[i]); qS[t * 136 + col] = f2bf(qv * __expf(bc[i]));
            vT[col * 72 + t] = vr[i]; }
        if (item + its < it1) HGO_LOAD_ROWS(item + its);
        __syncthreads();
        if (F.tid < 320) {
            const int task = F.tid, kq = task & 7, sb = (task >> 3) % 10, db = (task >> 3) / 10;
            const int bt = sb < 1 ? 0 : (sb < 3 ? 1 : (sb < 6 ? 2 : 3)), bs = sb - bt * (bt + 1) / 2;
            const int t0 = db * 16 + bt * 4, s0 = db * 16 + bs * 4;
            float a[4][4];
#pragma unroll
            for (int i = 0; i < 4; ++i)
#pragma unroll
                for (int j = 0; j < 4; ++j) a[i][j] = 0.f;
            for (int k2 = 0; k2 < 16; ++k2) { const int k = kq * 16 + k2;
                float qv[4], bq[4], kv[4], bk[4];
#pragma unroll
                for (int i = 0; i < 4; ++i) { qv[i] = bf2f(qL[(t0 + i) * 136 + k]); bq[i] = bL[(t0 + i) * 129 + k]; kv[i] = bf2f(kL[(s0 + i) * 136 + k]); bk[i] = bL[(s0 + i) * 129 + k]; }
#pragma unroll
                for (int i = 0; i < 4; ++i)
#pragma unroll
                    for (int j = 0; j < 4; ++j) a[i][j] += qv[i] * kv[j] * __expf(fminf(bq[i] - bk[j], 0.f)); }
#pragma unroll
            for (int i = 0; i < 4; ++i)
#pragma unroll
                for (int j = 0; j < 4; ++j) { float v = a[i][j]; v += __shfl_xor(v, 1); v += __shfl_xor(v, 2); v += __shfl_xor(v, 4); a[i][j] = v; }
            if (kq == 0) {
#pragma unroll
                for (int i = 0; i < 4; ++i)
#pragma unroll
                    for (int j = 0; j < 4; ++j) sc[(t0 + i) * 72 + s0 + j] = f2bf((s0 + j <= t0 + i) ? a[i][j] : 0.f);
            }
        }
        __syncthreads();
#pragma unroll 1
        for (int i = 1; i < 4; ++i) {
            const int nrow = 16 + 16 * i;
            for (int e = F.tid; e < nrow * 128; e += NTHREADS) { const int rr = e >> 7, k = e & 127;
                const float ref = bL[(16 * i - 1) * 129 + k];
                float v;
                if (rr < 16) { const int t = 16 * i + rr; v = bf2f(qL[t * 136 + k]) * __expf(bL[t * 129 + k] - ref); }
                else { const int s2 = rr - 16; v = bf2f(kL[s2 * 136 + k]) * __expf(ref - bL[s2 * 129 + k]); }
                stg[rr * 136 + k] = f2bf(v); }
            __syncthreads();
            if (F.wave < i) { const int j = F.wave; f32x4 acc = (f32x4){0.f, 0.f, 0.f, 0.f};
#pragma unroll
                for (int ks = 0; ks < 4; ++ks) acc = mma16(*(const LAS bf16x8*)(stg + r * 136 + ks * 32 + q * 8), *(const LAS bf16x8*)(stg + (16 + 16 * j + r) * 136 + ks * 32 + q * 8), acc);
#pragma unroll
                for (int ii = 0; ii < 4; ++ii) sc[(16 * i + 4 * q + ii) * 72 + 16 * j + r] = f2bf(acc[ii]); }
            __syncthreads();
        }
#pragma unroll
        for (int j = 0; j < 4; ++j) { const int i8 = (j * NTHREADS + F.tid) * 8; *(LAS u32x4*)(sT + (i8 >> 7) * 136 + (i8 & 127)) = st4[j]; }
        if (item + its < it1) HGO_LOAD_STATE(item + its);
        __syncthreads();
        f32x4 acc[4];
        {   const int tt = F.wave & 3, vg = F.wave >> 2;
#pragma unroll
            for (int j = 0; j < 4; ++j) acc[j] = (f32x4){0.f, 0.f, 0.f, 0.f};
#pragma unroll
            for (int ks = 0; ks < 4; ++ks) { const bf16x8 a = *(const LAS bf16x8*)(qS + (16 * tt + r) * 136 + ks * 32 + q * 8);
#pragma unroll
                for (int j = 0; j < 4; ++j) acc[j] = mma16(a, *(const LAS bf16x8*)(sT + (16 * (vg * 4 + j) + r) * 136 + ks * 32 + q * 8), acc[j]); }
#pragma unroll
            for (int ks = 0; ks < 2; ++ks) { const bf16x8 a = *(const LAS bf16x8*)(sc + (16 * tt + r) * 72 + ks * 32 + q * 8);
#pragma unroll
                for (int j = 0; j < 4; ++j) acc[j] = mma16(a, *(const LAS bf16x8*)(vT + (16 * (vg * 4 + j) + r) * 72 + ks * 32 + q * 8), acc[j]); }
#pragma unroll
            for (int j = 0; j < 4; ++j)
#pragma unroll
                for (int i = 0; i < 4; ++i) oL[(16 * tt + 4 * q + i) * 132 + 16 * (vg * 4 + j) + r] = acc[j][i];
        }
        __syncthreads();
        {   const int t = F.tid >> 3, seg = F.tid & 7; float v[16]; float ss = 0.f;
#pragma unroll
            for (int j = 0; j < 16; ++j) { v[j] = oL[t * 132 + seg * 16 + j]; ss += v[j] * v[j]; }
            ss += __shfl_xor(ss, 1); ss += __shfl_xor(ss, 2); ss += __shfl_xor(ss, 4);
            const float rs = rsqrtf(ss * (1.f / 128.f) + 1e-6f);
            const size_t grow = (size_t)b * SEQ + c * 64 + t;
            const bf16_t* gp = P + grow * NP + C_HG + h * 128 + seg * 16;
            const u32x4 g0 = *(const u32x4*)gp, g1 = *(const u32x4*)(gp + 8);
            float gv[16];
#pragma unroll
            for (int j = 0; j < 4; ++j) { gv[2 * j] = bflo(g0[j]); gv[2 * j + 1] = bfhi(g0[j]); gv[8 + 2 * j] = bflo(g1[j]); gv[8 + 2 * j + 1] = bfhi(g1[j]); }
            float o16[16];
#pragma unroll
            for (int j = 0; j < 16; ++j) o16[j] = v[j] * rs * nw[seg * 16 + j] * siluf_(gv[j]);
            bf16_t* op = OALL + grow * DM + h * 128 + seg * 16;
            *(u32x4*)op = (u32x4){cvtpk(o16[0], o16[1]), cvtpk(o16[2], o16[3]), cvtpk(o16[4], o16[5]), cvtpk(o16[6], o16[7])};
            *(u32x4*)(op + 8) = (u32x4){cvtpk(o16[8], o16[9]), cvtpk(o16[10], o16[11]), cvtpk(o16[12], o16[13]), cvtpk(o16[14], o16[15])};
        }
        __syncthreads();
    }
    q_post(F, qn);
}
#undef HGO_LOAD_ROWS
#undef HGO_LOAD_STATE
__device__ __forceinline__ void gmlp_phase(const Frame& F, int layer, int it0, int it1, int its) {
    LAS unsigned char* lds = F.lds;
    LAS bf16_t* vnT = (LAS bf16_t*)lds;
    LAS float* vmL = (LAS float*)(lds + 34816);
    const bf16_t* P = (const bf16_t*)(F.ws + WS_P); bf16_t* OALL = (bf16_t*)(F.ws + WS_OALL);
    const bf16_t* GMW = (const bf16_t*)(F.ws + WS_GMW) + (size_t)layer * 4 * 128 * 128;
    const float* lnw = F.inp(18) + layer * 512; const float* lnb = F.inp(19) + layer * 512; const float* bs = F.inp(21) + layer * 512;
    const int t = F.tid >> 2, q4 = F.tid & 3, r = F.lane & 15, q = F.lane >> 4, w = F.wave;
    for (int item = it0; item < it1; item += its) {
        const size_t row0 = (size_t)item * 128;
        const bf16_t* zr = P + (row0 + t) * NP + C_GZ;
        float sum = 0.f, sq = 0.f;
#pragma unroll
        for (int j = 0; j < 128; j += 8) { const u32x4 zz = *(const u32x4*)(zr + 512 + q4 * 128 + j);
#pragma unroll
            for (int e = 0; e < 4; ++e) { const float g0 = gelu_tanh(bflo(zz[e])), g1 = gelu_tanh(bfhi(zz[e])); sum += g0 + g1; sq += g0 * g0 + g1 * g1; } }
        sum += __shfl_xor(sum, 1); sum += __shfl_xor(sum, 2); sq += __shfl_xor(sq, 1); sq += __shfl_xor(sq, 2);
        const float mean = sum * (1.f / 512.f), var = fmaxf(sq * (1.f / 512.f) - mean * mean, 0.f), rstd = rsqrtf(var + 1e-5f);
        for (int g = 0; g < 4; ++g) {
#pragma unroll
            for (int j = 0; j < 32; j += 8) { const int cc = g * 128 + q4 * 32 + j; const u32x4 zz = *(const u32x4*)(zr + 512 + cc);
#pragma unroll
                for (int e = 0; e < 4; ++e) {
                    const float v0 = (gelu_tanh(bflo(zz[e])) - mean) * rstd * lnw[cc + 2 * e] + lnb[cc + 2 * e];
                    const float v1 = (gelu_tanh(bfhi(zz[e])) - mean) * rstd * lnw[cc + 2 * e + 1] + lnb[cc + 2 * e + 1];
                    vnT[(q4 * 32 + j + 2 * e) * 136 + t] = f2bf(v0); vnT[(q4 * 32 + j + 2 * e + 1) * 136 + t] = f2bf(v1); } }
            __syncthreads();
            f32x4 acc[8];
#pragma unroll
            for (int dt = 0; dt < 8; ++dt) acc[dt] = (f32x4){0.f, 0.f, 0.f, 0.f};
#pragma unroll
            for (int ks = 0; ks < 4; ++ks) { const bf16x8 a = *(const bf16x8*)(GMW + ((size_t)g * 128 + 16 * w + r) * 128 + ks * 32 + q * 8);
#pragma unroll
                for (int dt = 0; dt < 8; ++dt) acc[dt] = mma16(a, *(const LAS bf16x8*)(vnT + (16 * dt + r) * 136 + ks * 32 + q * 8), acc[dt]); }
#pragma unroll
            for (int i = 0; i < 4; ++i) { const int tt = 16 * w + 4 * q + i; const float bias = bs[g * 128 + tt];
#pragma unroll
                for (int dt = 0; dt < 8; ++dt) vmL[tt * 132 + 16 * dt + r] = acc[dt][i] + bias; }
            __syncthreads();
            {   const bf16_t* up = P + (row0 + t) * NP + C_GZ + g * 128 + q4 * 32; bf16_t* op = OALL + (row0 + t) * DM + 1536 + g * 128 + q4 * 32;
                u32x4 uu[4];
#pragma unroll
                for (int j = 0; j < 4; ++j) uu[j] = *(const u32x4*)(up + 8 * j);
#pragma unroll
                for (int j = 0; j < 4; ++j) { const f32x4 v0 = *(const LAS f32x4*)(vmL + t * 132 + q4 * 32 + 8 * j), v1 = *(const LAS f32x4*)(vmL + t * 132 + q4 * 32 + 8 * j + 4);
                    *(u32x4*)(op + 8 * j) = (u32x4){cvtpk(gelu_tanh(bflo(uu[j][0])) * v0[0], gelu_tanh(bfhi(uu[j][0])) * v0[1]), cvtpk(gelu_tanh(bflo(uu[j][1])) * v0[2], gelu_tanh(bfhi(uu[j][1])) * v0[3]),
                                                  cvtpk(gelu_tanh(bflo(uu[j][2])) * v1[0], gelu_tanh(bfhi(uu[j][2])) * v1[1]), cvtpk(gelu_tanh(bflo(uu[j][3])) * v1[2], gelu_tanh(bfhi(uu[j][3])) * v1[3])}; }
            }
            __syncthreads();
        }
    }
}
constexpr int NLP = 21, PH_LAYER0 = 3, PH_FINAL = PH_LAYER0 + NLP * DEPTH, NPH = PH_FINAL + 1;
struct Args { const float* in[32]; float* out; unsigned char* ws; int ph_lo, ph_hi; };

__global__ void __launch_bounds__(NTHREADS, 2) fwd_kernel(Args args) {
    extern __shared__ __attribute__((aligned(16))) unsigned char lds_raw[];
    Frame F0;
    F0.in = (const float* const __attribute__((address_space(4)))*)__builtin_amdgcn_kernarg_segment_ptr();
    F0.out = args.out; F0.ws = args.ws; F0.lds = (LAS unsigned char*)lds_raw;
    F0.wave = __builtin_amdgcn_readfirstlane((int)(threadIdx.x >> 6)); F0.lane = lane_id(); F0.tid = F0.wave * 64 + F0.lane; F0.G = gridDim.x; F0.wg = blockIdx.x;
    const int lo = args.ph_lo, hi = args.ph_hi;
    if (F0.tid == 0) *(LAS u32x4*)(F0.lds + LDS_BARW) = (u32x4){0u, 0u, 0u, 0u};
    __syncthreads();
    XcdBarrier bar; bar.bar = (unsigned*)(F0.ws + WS_CTL); bar.x = 0; bar.st = nullptr; bar.w0 = (F0.wave == 0);
    if (hi - lo > 1) bar = xcd_barrier_post((unsigned*)(F0.ws + WS_CTL), (volatile LAS unsigned*)(F0.lds + LDS_BARW), F0.wave == 0);
#ifndef PHSEL
#define PHSEL(t) true
#endif
#define IN(k) (lo <= (k) && (k) < hi)
#ifdef PROBE_DOUBLE_BARRIER
#define SEAM(k) do { if (IN(k) && IN((k) + 1)) { xcd_barrier(bar); xcd_barrier(bar); } } while (0)
#else
#define SEAM(k) do { if (IN(k) && IN((k) + 1)) xcd_barrier(bar); } while (0)
#endif
#define PHASE_FRAME Frame F = F0; { int t_; asm volatile("v_mbcnt_lo_u32_b32 %0, -1, 0\n\tv_mbcnt_hi_u32_b32 %0, -1, %0" : "=v"(t_)); t_ += F0.wave * 64; asm volatile("" : "+v"(t_)); F.tid = t_; F.lane = t_ & 63; F.wave = __builtin_amdgcn_readfirstlane(t_ >> 6); \
        size_t z_ = 0; asm volatile("" : "+s"(z_));     \
        F.ws = (unsigned char*)((GAS unsigned char*)F0.ws + z_); F.out = (float*)((GAS float*)F0.out + z_); \
        int g_ = F.wg; asm volatile("" : "+s"(g_)); F.wg = g_; } unsigned char* const ws = F.ws; (void)ws;

    if (PHSEL(0) && IN(0)) { PHASE_FRAME p0_prologue(F); SEAM(0); }
    if (PHSEL(1) && IN(1)) { PHASE_FRAME
        pg8::SchedKV S{F.G, F.wg, 2048, 2048, (const char*)(ws + WS_MEMN), (const char*)(ws + WS_WKVT)};
        pg8::EpiGen E{(bf16_t*)(ws + WS_KV), nullptr, 4096, 0, 1.f, 0};
        pg8::gemm_phase<pg8::EpiGen, pg8::SchedKV>(F.lds, F.tid, S, E);
        SEAM(1);
    }
    if (PHSEL(2) && IN(2)) { PHASE_FRAME
        {   pg8::SchedWQK S{F.G, F.wg, 4096, 2048, (const char*)(ws + WS_KV), (const char*)(ws + WS_WQB)};
            pg8::EpiGen E{(bf16_t*)(ws + WS_WQK), nullptr, 2048, 2, 0.044194173824159216f * GATE_WSCALE, 0};
            pg8::gemm_phase<pg8::EpiGen, pg8::SchedWQK>(F.lds, F.tid, S, E); }
        {   pg8::SchedVWO S{F.G, F.wg, 2048, 4096, (const char*)(ws + WS_WOT), (const char*)(ws + WS_KV)};
            pg8::EpiGen E{(bf16_t*)(ws + WS_VWO), nullptr, 1024, 2, GATE_WSCALE, 0};
            pg8::gemm_phase<pg8::EpiGen, pg8::SchedVWO>(F.lds, F.tid, S, E); }
        SEAM(2);
    }
    for (int l = 0; l < DEPTH; ++l) {
        const int pb = PH_LAYER0 + NLP * l;
        if (PHSEL(4) && IN(pb + 1)) { PHASE_FRAME
            pg8::SchedStd S{128, 24, F.G, F.wg, 32, 2048, 2048, (const char*)(ws + WS_H), (const char*)(ws + WS_WIN) + (size_t)l * NP * DM * 2, 0};
            pg8::EpiInProj E{(bf16_t*)(ws + WS_P), (bf16_t*)(ws + WS_CK), (bf16_t*)(ws + WS_CV), (const float*)(ws + WS_SS), F.lds};
            pg8::gemm_phase<pg8::EpiInProj, pg8::SchedStd>(F.lds, F.tid, S, E);
            SEAM(pb + 1);
        }
        if (PHSEL(5) && IN(pb + 2)) { PHASE_FRAME
            unsigned* ctr = (unsigned*)(ws + WS_CTL + 16384) + (l * 4 + 0) * 64;
            int it = q_next(F, ctr);
            while (it < 1024) { { int t_ = F.tid; asm volatile("" : "+v"(t_)); F.tid = t_; } at::diff_attn_item(F, l, it & 7, 127 - (it >> 3), ctr); it = q_read(F); }
            while (it < 1040) { { int t_ = F.tid; asm volatile("" : "+v"(t_)); F.tid = t_; }
                pg8::SchedCmpOne S{it - 1024, 2048, 4096, (const char*)(ws + WS_CK), (const char*)(ws + WS_CW1) + (size_t)l * 2 * 256 * 4096 * 2};
                pg8::EpiGen E{(bf16_t*)(ws + WS_HC), (const float*)(ws + WS_TAB) + TAB_CBIAS / 4 + l * 512, 256, 1, 1.f, 0};
                pg8::gemm_phase<pg8::EpiGen, pg8::SchedCmpOne>(F.lds, F.tid, S, E); it = q_next(F, ctr); }
            while (it < 1296) { { int t_ = F.tid; asm volatile("" : "+v"(t_)); F.tid = t_; } gmlp_phase(F, l, it - 1040, it - 1039, 1); it = q_next(F, ctr); }
            while (it < 1808) { { int t_ = F.tid; asm volatile("" : "+v"(t_)); F.tid = t_; } hgrn_local(F, l, (it - 1296) * 4, (it - 1296) * 4 + 4, 1, ctr); it = q_read(F); }
            SEAM(pb + 2); }
        if (PHSEL(6) && IN(pb + 3)) { PHASE_FRAME hgrn_scan(F); compress2(F, l); SEAM(pb + 3); }
        if (PHSEL(7) && IN(pb + 4)) { PHASE_FRAME
            unsigned* ctr = (unsigned*)(ws + WS_CTL + 16384) + (l * 4 + 1) * 64;
            int it = q_next(F, ctr);
            while (it < 512) { { int t_ = F.tid; asm volatile("" : "+v"(t_)); F.tid = t_; } at::nsa_item(F, it & 1, 255 - (it >> 1), ctr); it = q_read(F); }
            while (it < 1024) { { int t_ = F.tid; asm volatile("" : "+v"(t_)); F.tid = t_; } hgrn_out(F, l, (it - 512) * 4, (it - 512) * 4 + 4, 1, ctr); it = q_read(F); }
            SEAM(pb + 4); }
        if (PHSEL(15) && IN(pb + 12)) { PHASE_FRAME
            pg8::SchedMerge S{F.G, F.wg, 2048, 2048, (const char*)(ws + WS_WG + 2048), (const char*)(ws + WS_OALL),
                              (const char*)(ws + WS_WG) + (size_t)l * 8192 * DM * 2, (const char*)(ws + WS_WB) + (size_t)l * DM * DM * 2};
            pg8::EpiMerge E{(bf16_t*)(ws + WS_GSCR + (size_t)F.wg * 131072), (bf16_t*)(ws + WS_MACC + (size_t)F.wg * 131072), (bf16_t*)(ws + WS_MRG), (const float*)(ws + WS_SS), F.lds};
            pg8::gemm_phase<pg8::EpiMerge, pg8::SchedMerge>(F.lds, F.tid, S, E);
            SEAM(pb + 12);
        }
        if (PHSEL(16) && IN(pb + 13)) { PHASE_FRAME
            pg8::SchedStd S{128, 8, F.G, F.wg, 32, 2048, 2048, (const char*)(ws + WS_MRG), (const char*)(ws + WS_WO) + (size_t)l * DM * DM * 2, 0};
            pg8::EpiResid E{(bf16_t*)(ws + WS_H), (float*)(ws + WS_SS), (LAS float*)(F.lds + 131072), ws + WS_WG + 2048, 1.f, 0};
            pg8::gemm_phase<pg8::EpiResid, pg8::SchedStd>(F.lds, F.tid, S, E);
            SEAM(pb + 13);
        }
        if (PHSEL(18) && IN(pb + 15)) { PHASE_FRAME
            pg8::SchedStd8 S{128, 4, F.G, F.wg, 16, 2048, 1024, (const char*)(ws + WS_WG + 2048), (const char*)(ws + WS_WQK) + (size_t)l * 2 * 1024 * 2048, 1024ull * 2048};
            pg8::EpiXaSoftmax E{(bf16_t*)(ws + WS_PXA), (const float*)(ws + WS_SS), F.lds};
            pg8::gemm_phase<pg8::EpiXaSoftmax, pg8::SchedStd8>(F.lds, F.tid, S, E);
            SEAM(pb + 15);
        }
        if (PHSEL(20) && IN(pb + 17)) { PHASE_FRAME
            pg8::SchedStd8 S{128, 8, F.G, F.wg, 8, 512, 512, (const char*)(ws + WS_PXA), (const char*)(ws + WS_VWO) + (size_t)l * 2 * 2048 * 1024, 2048ull * 1024};
            pg8::EpiResid E{(bf16_t*)(ws + WS_H), (float*)(ws + WS_SS), (LAS float*)(F.lds + 131072), nullptr, 1.f / (XA_PSCALE * GATE_WSCALE), 0};
            pg8::gemm_phase<pg8::EpiResid, pg8::SchedStd8>(F.lds, F.tid, S, E);
            SEAM(pb + 17);
        }
        if (PHSEL(22) && IN(pb + 19)) { PHASE_FRAME
            pg8::SchedStd S{128, 44, F.G, F.wg, 32, 2048, 2048, (const char*)(ws + WS_H), (const char*)(ws + WS_FF1) + (size_t)l * 2 * DFF * DM * 2, 0};
            pg8::EpiFfn1 E{(bf16_t*)(ws + WS_HID), (const float*)(ws + WS_SS), F.lds};
            pg8::gemm_phase<pg8::EpiFfn1, pg8::SchedStd>(F.lds, F.tid, S, E);
            SEAM(pb + 19);
        }
        if (PHSEL(23) && IN(pb + 20)) { PHASE_FRAME
            pg8::SchedStd S{128, 8, F.G, F.wg, 88, 5632, 5632, (const char*)(ws + WS_HID), (const char*)(ws + WS_FF2) + (size_t)l * DM * DFF * 2, 0};
            pg8::EpiResid E{(bf16_t*)(ws + WS_H), (float*)(ws + WS_SS), (LAS float*)(F.lds + 131072), (l + 1 < DEPTH) ? ws + WS_WG + 2048 : nullptr, 1.f, 0};
            pg8::gemm_phase<pg8::EpiResid, pg8::SchedStd>(F.lds, F.tid, S, E);
            SEAM(pb + 20);
        }
    }
    if (PHSEL(24) && IN(PH_FINAL)) { PHASE_FRAME final_norm(F, F.out, F.inp(31), (const float*)(ws + WS_SS)); }
#undef IN
#undef SEAM
}

extern "C" void kernel_launch(void* const* d_in, const int* in_sizes, int n_in, void* d_out, int out_size, void* d_ws, size_t ws_size, hipStream_t stream) {
    static int grid = 0;
    if (grid == 0) {
        if (n_in != 32 || in_sizes[0] != MT * DM || out_size != MT * DM || ws_size < WS_END) {
            fprintf(stderr, "kernel_launch: unexpected shapes (n_in %d, in0 %d, out %d, ws %zu, need %zu); nothing launched\n", n_in, n_in > 0 ? in_sizes[0] : -1, out_size, ws_size, (size_t)WS_END);
            grid = -1; return; }
        int dev = 0, cus = 0, per_cu = 0;
        if (hipGetDevice(&dev) != hipSuccess || hipDeviceGetAttribute(&cus, hipDeviceAttributeMultiprocessorCount, dev) != hipSuccess) { grid = -1; return; }
        if (hipFuncSetAttribute((const void*)fwd_kernel, hipFuncAttributeMaxDynamicSharedMemorySize, LDS_BYTES) != hipSuccess) { fprintf(stderr, "kernel_launch: hipFuncSetAttribute failed\n"); grid = -1; return; }
        if (hipOccupancyMaxActiveBlocksPerMultiprocessor(&per_cu, (const void*)fwd_kernel, NTHREADS, LDS_BYTES) != hipSuccess || per_cu < 1)
            fprintf(stderr, "kernel_launch: note: occupancy query reports %d workgroups per CU\n", per_cu);
        (void)hipGetLastError();
        grid = cus;
    }
    if (grid < 0) return;
    (void)hipMemsetAsync((char*)d_ws + WS_CTL, 0, 65536, stream);
    Args a{};
    for (int i = 0; i < 32; ++i) a.in[i] = (const float*)d_in[i];
    a.out = (float*)d_out; a.ws = (unsigned char*)d_ws;
#if MK_N_LAUNCHES == 1
    a.ph_lo = 0; a.ph_hi = NPH;
    hipLaunchKernelGGL(fwd_kernel, dim3(grid), dim3(NTHREADS), LDS_BYTES, stream, a);
#else
    auto run = [&](int p) { a.ph_lo = p; a.ph_hi = p + 1; hipLaunchKernelGGL(fwd_kernel, dim3(grid), dim3(NTHREADS), LDS_BYTES, stream, a); };
    for (int p = 0; p < PH_FINAL; ++p) run(p);
    run(PH_FINAL);
#endif
}
```
